# Optimizing an MI355X kernel written in HIP

```python
import math
import jax, jax.numpy as jnp
from jax import lax
import numpy as np

D_MODEL = 1024
BATCH = 4
SEQ = 4096
DEPTH = 2

N_EVEN = (DEPTH + 1) // 2
N_ODD = DEPTH // 2
ALPHA = (2.0 * DEPTH) ** 0.25
BETA = (8.0 * DEPTH) ** -0.25
LN_EPS = 1e-5

CONV_DIM = D_MODEL // 2
CONV_WIDTH = 31
SGU_DIM = D_MODEL // 2
SGU_GROUPS = 4
SGU_GROUP_DIM = SGU_DIM // SGU_GROUPS
CHUNK = 128
AB_IN = 2 * CONV_DIM + 2 * SGU_DIM
AB_MIX = CONV_DIM + SGU_DIM

RWKV_HEAD = 64
RWKV_HEADS = D_MODEL // RWKV_HEAD
DECAY_LORA = 64
AAA_LORA = 64
GATE_LORA = 128
GN_EPS = 64e-5

FFN_HIDDEN = -(-8 * D_MODEL // (3 * 256)) * 256

kernel_name = 'hybrid_conv_sgu_rwkv7_deepnorm'


def _layer_norm(x, g, b, eps=LN_EPS):
    xf = x.astype(jnp.float32)
    mu = jnp.mean(xf, axis=-1, keepdims=True)
    var = jnp.mean(jnp.square(xf - mu), axis=-1, keepdims=True)
    return ((xf - mu) * lax.rsqrt(var + eps) * g + b).astype(x.dtype)


def conv_sgu_mixer(x, w_in, b_in, conv_w, conv_b, cn_g, cn_b, sn_g, sn_b, sgu_w, sgu_b, w_out, b_out):
    bsz, s, _ = x.shape
    h = jnp.einsum('bsd,de->bse', x, w_in) + b_in
    a_val, a_gate, u, v = jnp.split(h, [CONV_DIM, 2 * CONV_DIM, 2 * CONV_DIM + SGU_DIM], axis=-1)
    y = a_val * jax.nn.sigmoid(a_gate)
    y = lax.conv_general_dilated(
        y, conv_w, window_strides=(1,), padding=((CONV_WIDTH - 1, 0),),
        dimension_numbers=('NWC', 'WIO', 'NWC'), feature_group_count=CONV_DIM) + conv_b
    y = jax.nn.silu(_layer_norm(y, cn_g, cn_b))
    u = jax.nn.gelu(u)
    v = _layer_norm(jax.nn.gelu(v), sn_g, sn_b)
    v = v.reshape(bsz, s // CHUNK, CHUNK, SGU_GROUPS, SGU_GROUP_DIM)
    causal = jnp.tril(jnp.ones((CHUNK, CHUNK), dtype=bool))
    w_s = jnp.where(causal[None], sgu_w, jnp.zeros((), sgu_w.dtype))
    sv = jnp.einsum('gts,bcsgd->bctgd', w_s, v) + jnp.transpose(sgu_b)[:, :, None]
    z = u * sv.reshape(bsz, s, SGU_DIM)
    mixed = jnp.concatenate([y, z], axis=-1)
    return jnp.einsum('bse,ed->bsd', mixed, w_out) + b_out


def rwkv7_time_mix(x, mu, w_rkv, w0, w_w1, w_w2, a0, a_w1, a_w2, g_w1, g_w2,
                   k_k, k_a, r_k, ln_g, ln_b, w_out):
    bsz, s, d = x.shape
    x_prev = jnp.pad(x, ((0, 0), (1, 0), (0, 0)))[:, :-1]
    xx = x_prev - x
    xr, xw, xk, xv, xa, xg = [x + xx * mu[i] for i in range(6)]
    r, k, v = jnp.einsum('nbsd,nde->nbse', jnp.stack([xr, xk, xv]), w_rkv)
    w_log = -jax.nn.softplus(-(w0 + jnp.tanh(xw @ w_w1) @ w_w2)) - 0.5
    decay = jnp.exp(-jnp.exp(w_log.astype(jnp.float32)))
    a = jax.nn.sigmoid(a0 + (xa @ a_w1) @ a_w2)
    g = jax.nn.sigmoid(xg @ g_w1) @ g_w2
    hs = (bsz, s, RWKV_HEADS, RWKV_HEAD)
    kk = (k * k_k).reshape(hs).astype(jnp.float32)
    kk = kk / jnp.maximum(jnp.linalg.norm(kk, axis=-1, keepdims=True), 1e-12)
    k = k * (1 + (a - 1) * k_a)
    rf = r.reshape(hs).astype(jnp.float32)
    kf = k.reshape(hs).astype(jnp.float32)
    vf = v.reshape(hs).astype(jnp.float32)
    af = a.reshape(hs).astype(jnp.float32)
    wf = decay.reshape(hs)

    def step(state, inp):
        r_t, w_t, k_t, v_t, kk_t, a_t = inp
        sa = jnp.einsum('bhij,bhj->bhi', state, -kk_t)
        state = (state * w_t[:, :, None, :]
                 + sa[..., None] * (kk_t * a_t)[:, :, None, :]
                 + v_t[..., None] * k_t[:, :, None, :])
        return state, jnp.einsum('bhij,bhj->bhi', state, r_t)

    seq_first = lambda t: jnp.swapaxes(t, 0, 1)
    state0 = jnp.zeros((bsz, RWKV_HEADS, RWKV_HEAD, RWKV_HEAD), jnp.float32)
    _, y = lax.scan(step, state0, tuple(seq_first(t) for t in (rf, wf, kf, vf, kk, af)))
    y = jnp.swapaxes(y, 0, 1)
    ym = jnp.mean(y, axis=-1, keepdims=True)
    yv = jnp.mean(jnp.square(y - ym), axis=-1, keepdims=True)
    y = ((y - ym) * lax.rsqrt(yv + GN_EPS)).reshape(bsz, s, d) * ln_g + ln_b
    bonus = jnp.sum(rf * kf * r_k, axis=-1, keepdims=True) * vf
    y = y + bonus.reshape(bsz, s, d)
    return ((y * g) @ w_out).astype(x.dtype)


def swiglu_ffn(x, w_in, w_out):
    gate, up = jnp.split(x @ w_in, 2, axis=-1)
    return (jax.nn.silu(gate) * up) @ w_out


def setup_inputs(seed: int = 0) -> dict:
    key = jax.random.key(seed)
    ks = iter(jax.random.split(key, 48))
    nrm = lambda shape, scale: scale * jax.random.normal(next(ks), shape, jnp.float32)
    gain = lambda shape: 1.0 + nrm(shape, 0.02)
    D = D_MODEL
    inp = {}
    inp['x'] = nrm((BATCH, SEQ, D), 1.0)
    inp['ab_w_in'] = nrm((N_EVEN, D, AB_IN), D ** -0.5)
    inp['ab_b_in'] = nrm((N_EVEN, AB_IN), 0.02)
    inp['conv_w'] = nrm((N_EVEN, CONV_WIDTH, 1, CONV_DIM), CONV_WIDTH ** -0.5)
    inp['conv_b'] = nrm((N_EVEN, CONV_DIM), 0.02)
    inp['conv_norm_g'] = gain((N_EVEN, CONV_DIM))
    inp['conv_norm_b'] = nrm((N_EVEN, CONV_DIM), 0.02)
    inp['sgu_norm_g'] = gain((N_EVEN, SGU_DIM))
    inp['sgu_norm_b'] = nrm((N_EVEN, SGU_DIM), 0.02)
    inp['sgu_w'] = nrm((N_EVEN, SGU_GROUPS, CHUNK, CHUNK), CHUNK ** -0.5)
    inp['sgu_b'] = 1.0 + nrm((N_EVEN, SGU_GROUPS, CHUNK), 0.1)
    inp['ab_w_out'] = nrm((N_EVEN, AB_MIX, D), BETA * AB_MIX ** -0.5)
    inp['ab_b_out'] = nrm((N_EVEN, D), 0.02)
    inp['rwkv_mu'] = jax.random.uniform(next(ks), (N_ODD, 6, D), jnp.float32)
    inp['rwkv_w_rkv'] = nrm((N_ODD, 3, D, D), D ** -0.5)
    inp['rwkv_w0'] = jax.random.uniform(next(ks), (N_ODD, D), jnp.float32, -6.0, 0.0)
    inp['rwkv_w_w1'] = nrm((N_ODD, D, DECAY_LORA), D ** -0.5)
    inp['rwkv_w_w2'] = nrm((N_ODD, DECAY_LORA, D), 0.1 * DECAY_LORA ** -0.5)
    inp['rwkv_a0'] = nrm((N_ODD, D), 0.1)
    inp['rwkv_a_w1'] = nrm((N_ODD, D, AAA_LORA), D ** -0.5)
    inp['rwkv_a_w2'] = nrm((N_ODD, AAA_LORA, D), 0.1 * AAA_LORA ** -0.5)
    inp['rwkv_g_w1'] = nrm((N_ODD, D, GATE_LORA), D ** -0.5)
    inp['rwkv_g_w2'] = nrm((N_ODD, GATE_LORA, D), GATE_LORA ** -0.5)
    inp['rwkv_k_k'] = 0.85 + nrm((N_ODD, D), 0.02)
    inp['rwkv_k_a'] = gain((N_ODD, D))
    inp['rwkv_r_k'] = nrm((N_ODD, RWKV_HEADS, RWKV_HEAD), 0.1)
    inp['rwkv_ln_g'] = gain((N_ODD, D))
    inp['rwkv_ln_b'] = nrm((N_ODD, D), 0.02)
    inp['rwkv_w_out'] = nrm((N_ODD, D, D), BETA * D ** -0.5)
    inp['ffn_w_in'] = nrm((DEPTH, D, 2 * FFN_HIDDEN), D ** -0.5)
    inp['ffn_w_out'] = nrm((DEPTH, FFN_HIDDEN, D), BETA * FFN_HIDDEN ** -0.5)
    inp['ln_mix_g'] = gain((DEPTH, D))
    inp['ln_mix_b'] = nrm((DEPTH, D), 0.02)
    inp['ln_ffn_g'] = gain((DEPTH, D))
    inp['ln_ffn_b'] = nrm((DEPTH, D), 0.02)
    return inp


def reference(x, ab_w_in, ab_b_in, conv_w, conv_b, conv_norm_g, conv_norm_b,
              sgu_norm_g, sgu_norm_b, sgu_w, sgu_b, ab_w_out, ab_b_out,
              rwkv_mu, rwkv_w_rkv, rwkv_w0, rwkv_w_w1, rwkv_w_w2, rwkv_a0,
              rwkv_a_w1, rwkv_a_w2, rwkv_g_w1, rwkv_g_w2, rwkv_k_k, rwkv_k_a,
              rwkv_r_k, rwkv_ln_g, rwkv_ln_b, rwkv_w_out,
              ffn_w_in, ffn_w_out, ln_mix_g, ln_mix_b, ln_ffn_g, ln_ffn_b):
    for layer in range(DEPTH):
        i = layer // 2
        if layer % 2 == 0:
            mix = conv_sgu_mixer(x, ab_w_in[i], ab_b_in[i], conv_w[i], conv_b[i],
                                 conv_norm_g[i], conv_norm_b[i], sgu_norm_g[i], sgu_norm_b[i],
                                 sgu_w[i], sgu_b[i], ab_w_out[i], ab_b_out[i])
        else:
            mix = rwkv7_time_mix(x, rwkv_mu[i], rwkv_w_rkv[i], rwkv_w0[i], rwkv_w_w1[i],
                                 rwkv_w_w2[i], rwkv_a0[i], rwkv_a_w1[i], rwkv_a_w2[i],
                                 rwkv_g_w1[i], rwkv_g_w2[i], rwkv_k_k[i], rwkv_k_a[i],
                                 rwkv_r_k[i], rwkv_ln_g[i], rwkv_ln_b[i], rwkv_w_out[i])
        x = _layer_norm(ALPHA * x + mix, ln_mix_g[layer], ln_mix_b[layer])
        x = _layer_norm(ALPHA * x + swiglu_ffn(x, ffn_w_in[layer], ffn_w_out[layer]),
                        ln_ffn_g[layer], ln_ffn_b[layer])
    return x
```

```cpp
#include <hip/hip_runtime.h>
#include <hip/hip_cooperative_groups.h>
#include <cstdio>
namespace cg = cooperative_groups;

#ifndef PER_PHASE_LAUNCH
#define PER_PHASE_LAUNCH 0
#endif

#ifndef STOP_AFTER
#define STOP_AFTER 99
#endif
#ifndef DUMP_OFF
#define DUMP_OFF SLOTP(2)
#endif
#ifndef ONLY
#define ONLY -1
#endif
#define LAS __attribute__((address_space(3)))
typedef unsigned short bf16_t;
typedef short bf16x8 __attribute__((ext_vector_type(8)));
typedef float f32x4 __attribute__((ext_vector_type(4)));
typedef unsigned u32x4 __attribute__((ext_vector_type(4)));
typedef unsigned u32x2 __attribute__((ext_vector_type(2)));

constexpr int MT = 16384, DM = 1024, SEQL = 4096, FH = 2816;
constexpr float ALPHA = 1.41421356237f;
constexpr size_t MiB = 1ull << 20;
constexpr size_t O_WRKV = 0;
constexpr size_t O_WL1 = 6 * MiB;
constexpr size_t O_L2T = 7 * MiB;
constexpr size_t O_WOT = 8 * MiB + 512 * 1024;
constexpr size_t O_F1T1 = 10 * MiB + 512 * 1024;
constexpr size_t O_F2T1 = 21 * MiB + 512 * 1024;
constexpr size_t O_W1T = 27 * MiB;
constexpr size_t O_W2T = 31 * MiB;
constexpr size_t O_F1T0 = 33 * MiB;
constexpr size_t O_F2T0 = 44 * MiB;
constexpr size_t O_CT = 50 * MiB;
constexpr size_t O_SLOT = 52 * MiB;
constexpr size_t SLOT = 32 * MiB + 64 * 1024;
constexpr size_t O_HID = O_SLOT + 6 * SLOT;
constexpr size_t WS_END = O_HID + 8 * MiB;
#define SLOTP(i) (O_SLOT + (size_t)(i) * SLOT)

struct Args { const float* in[35]; float* out; unsigned char* ws; int ph_lo, ph_hi; };

__device__ __forceinline__ float bf2f(bf16_t v) { return __uint_as_float((unsigned)v << 16); }
typedef float f32x2 __attribute__((ext_vector_type(2)));
typedef __bf16 bf16x2n __attribute__((ext_vector_type(2)));
__device__ __forceinline__ unsigned cvt_pk_bf16(float lo, float hi) { const f32x2 v = {lo, hi}; return __builtin_bit_cast(unsigned, __builtin_convertvector(v, bf16x2n)); }
__device__ __forceinline__ bf16_t f2bf(float f) { return (bf16_t)(cvt_pk_bf16(f, 0.f) & 0xffffu); }
__device__ __forceinline__ float sigmoidf_(float z) { return __builtin_amdgcn_rcpf(1.0f + __expf(-z)); }
__device__ __forceinline__ float gelu_tanh(float x) { return x * sigmoidf_(1.5957691216f * (x + 0.044715f * x * x * x)); }
__device__ __forceinline__ int tid_opaque() { int t = threadIdx.x; asm volatile("" : "+v"(t)); return t; }
__device__ __forceinline__ float wave_sum(float v) {
#pragma unroll
    for (int o = 32; o; o >>= 1) v += __shfl_xor(v, o);
    return v;
}
__device__ __forceinline__ u32x2 pack4(f32x4 v) { u32x2 w; w.x = cvt_pk_bf16(v[0], v[1]); w.y = cvt_pk_bf16(v[2], v[3]); return w; }
__device__ __forceinline__ void unpack8(u32x4 r, float (&f)[8]) {
#pragma unroll
    for (int i = 0; i < 4; ++i) { f[2 * i] = __uint_as_float(r[i] << 16); f[2 * i + 1] = __uint_as_float(r[i] & 0xffff0000u); }
}

constexpr int BM = 256, BK = 64, HALF = 128, HTB = HALF * BK * 2, STAGE_BYTES = 8 * HTB, NXCD = 8, WGM = 8;
__device__ __forceinline__ int lds_byte(int r, int c) { const int st = (r >> 4) * 2 + (c >> 5), rr = r & 15, cc = c & 31, ob = rr * 64 + cc * 2; return st * 1024 + (ob ^ (((ob >> 9) & 1) << 5)); }
__device__ __forceinline__ void stage_rc(int b, int& R, int& C) { const int st = b / 1024, sb = b % 1024, swz = sb ^ (((sb >> 9) & 1) << 5); R = (st >> 1) * 16 + swz / 64; C = (st & 1) * 32 + (swz % 64) / 2; }

struct Unit { int pm, pn, tag; size_t aoff, boff; };
__device__ __forceinline__ void remap_tile(int wgid, int nM, int nN, int& pm, int& pn) {
    const int nwg = nM * nN;
    { const int q = nwg / NXCD, r = nwg % NXCD, xcd = wgid % NXCD, off = wgid / NXCD; wgid = (xcd < r ? xcd * (q + 1) : r * (q + 1) + (xcd - r) * q) + off; }
    const int nig = WGM * nN, gid = wgid / nig, fm = gid * WGM, gsz = (nM - fm) < WGM ? (nM - fm) : WGM;
    pm = fm + ((wgid % nig) % gsz); pn = (wgid % nig) / gsz;
}
struct StaticOrder {
    int nM, nN; size_t ldaB, ldbB;
    __device__ __forceinline__ bool next(int i, Unit& u) const {
        const long L = (long)i * gridDim.x + blockIdx.x; if (L >= (long)nM * nN) return false;
        remap_tile((int)L, nM, nN, u.pm, u.pn); u.tag = 0; u.aoff = (size_t)u.pm * BM * ldaB; u.boff = (size_t)u.pn * BM * ldbB; return true;
    }
};
struct GroupOrder {
    int ngr; size_t astride;
    __device__ __forceinline__ bool next(int i, Unit& u) const {
        const long L = (long)i * gridDim.x + blockIdx.x; if (L >= (long)ngr * 256) return false;
        const int g = (int)(L >> 8); remap_tile((int)(L & 255), 64, 4, u.pm, u.pn); u.tag = g;
        u.aoff = (size_t)g * astride + (size_t)u.pm * BM * 2048; u.boff = (size_t)(g * 4 + u.pn) * BM * 2048; return true;
    }
};
struct LoraOrder {
    __device__ __forceinline__ bool next(int i, Unit& u) const {
        const long L = (long)i * gridDim.x + blockIdx.x; if (L >= 64) return false;
        u.pm = (int)L; u.pn = 0; u.tag = 0; u.aoff = (size_t)(256 * u.pm + (u.pm >> 4)) * 2048; u.boff = 0; return true;
    }
};

#define EPI_ROWS(ai, m) (u.pm * BM + (ai) * HALF + wr * 64 + (m) * 16 + fr)
#define EPI_CL(n) (wc * 32 + (n) * 16 + 4 * fq)
typedef f32x4 AccT[2][2][4][2];

struct EpiG1 {
    bf16_t* ypre; bf16_t* ug; bf16_t* vg; const float* bias;
    __device__ __forceinline__ void operator()(const AccT& acc, const Unit& u, int wr, int wc, int fr, int fq) const {
        if (u.pn < 4) {
#pragma unroll
            for (int n = 0; n < 2; ++n) {
                const int cl = EPI_CL(n); const f32x4 bv = *(const f32x4*)(bias + 128 * u.pn + cl), bg = *(const f32x4*)(bias + 512 + 128 * u.pn + cl);
#pragma unroll
                for (int ai = 0; ai < 2; ++ai)
#pragma unroll
                    for (int m = 0; m < 4; ++m) { const f32x4 val = acc[ai][0][m][n] + bv, gate = acc[ai][1][m][n] + bg; f32x4 y;
#pragma unroll
                        for (int j = 0; j < 4; ++j) y[j] = val[j] * sigmoidf_(gate[j]);
                        *(u32x2*)(ypre + (size_t)EPI_ROWS(ai, m) * 512 + 128 * u.pn + cl) = pack4(y); }
            }
        } else {
            bf16_t* dst = u.pn < 6 ? ug : vg; const int cb = (u.pn & 1) * 256;
#pragma unroll
            for (int bj = 0; bj < 2; ++bj)
#pragma unroll
                for (int n = 0; n < 2; ++n) {
                    const int cl = bj * HALF + EPI_CL(n); const f32x4 bv = *(const f32x4*)(bias + 256 * u.pn + cl);
#pragma unroll
                    for (int ai = 0; ai < 2; ++ai)
#pragma unroll
                        for (int m = 0; m < 4; ++m) { const f32x4 v = acc[ai][bj][m][n] + bv; f32x4 y;
#pragma unroll
                            for (int j = 0; j < 4; ++j) y[j] = gelu_tanh(v[j]);
                            *(u32x2*)(dst + (size_t)EPI_ROWS(ai, m) * 512 + cb + cl) = pack4(y); }
                }
        }
    }
};
struct EpiRes {
    const float* res; float* out; const float* bias;
    __device__ __forceinline__ void operator()(const AccT& acc, const Unit& u, int wr, int wc, int fr, int fq) const {
#pragma unroll
        for (int bj = 0; bj < 2; ++bj)
#pragma unroll
            for (int n = 0; n < 2; ++n) {
                const int col = u.pn * BM + bj * HALF + EPI_CL(n); const f32x4 bv = bias ? *(const f32x4*)(bias + col) : (f32x4){0.f, 0.f, 0.f, 0.f};
#pragma unroll
                for (int ai = 0; ai < 2; ++ai)
#pragma unroll
                    for (int m = 0; m < 4; ++m) { const size_t off = (size_t)EPI_ROWS(ai, m) * DM + col; const f32x4 r4 = *(const f32x4*)(res + off);
                        *(f32x4*)(out + off) = r4 * ALPHA + acc[ai][bj][m][n] + bv; }
            }
    }
};
struct EpiSwiglu {
    bf16_t* hmid;
    __device__ __forceinline__ void operator()(const AccT& acc, const Unit& u, int wr, int wc, int fr, int fq) const {
#pragma unroll
        for (int n = 0; n < 2; ++n) {
            const int col = 128 * u.pn + EPI_CL(n);
#pragma unroll
            for (int ai = 0; ai < 2; ++ai)
#pragma unroll
                for (int m = 0; m < 4; ++m) { const f32x4 g = acc[ai][0][m][n], up = acc[ai][1][m][n]; f32x4 y;
#pragma unroll
                    for (int j = 0; j < 4; ++j) y[j] = g[j] * sigmoidf_(g[j]) * up[j];
                    *(u32x2*)(hmid + (size_t)EPI_ROWS(ai, m) * FH + col) = pack4(y); }
        }
    }
};
template <int MODE> struct EpiBf {
    bf16_t* dst; bf16_t* dst2; size_t gstride; const float* p0; const float* p1;
    __device__ __forceinline__ void operator()(const AccT& acc, const Unit& u, int wr, int wc, int fr, int fq) const {
#pragma unroll
        for (int bj = 0; bj < 2; ++bj)
#pragma unroll
            for (int n = 0; n < 2; ++n) {
                const int col = u.pn * BM + bj * HALF + EPI_CL(n);
                f32x4 pv = (f32x4){0.f, 0.f, 0.f, 0.f};
                if (MODE == 2 || MODE == 4) pv = *(const f32x4*)(p0 + col);
#pragma unroll
                for (int ai = 0; ai < 2; ++ai)
#pragma unroll
                    for (int m = 0; m < 4; ++m) {
                        const size_t row = (size_t)EPI_ROWS(ai, m); f32x4 v = acc[ai][bj][m][n];
                        if (MODE == 0) { *(u32x2*)(dst + (size_t)u.tag * gstride + row * DM + col) = pack4(v); }
                        if (MODE == 3) { *(u32x2*)(dst + row * 512 + col) = pack4(v); }
                        if (MODE == 1) {
                            if (col < 64) {
#pragma unroll
                                for (int j = 0; j < 4; ++j) v[j] = 2.0f * sigmoidf_(2.0f * v[j]) - 1.0f;
                            } else if (col >= 128) {
#pragma unroll
                                for (int j = 0; j < 4; ++j) v[j] = sigmoidf_(v[j]);
                            }
                            *(u32x2*)(dst + row * 256 + col) = pack4(v);
                        }
                        if (MODE == 2) {
                            v += pv;
#pragma unroll
                            for (int j = 0; j < 4; ++j) v[j] = 0.60653066f * sigmoidf_(v[j]);
                            *(u32x2*)(dst + row * DM + col) = pack4(v);
                        }
                        if (MODE == 4) {
                            v += pv;
#pragma unroll
                            for (int j = 0; j < 4; ++j) v[j] = sigmoidf_(v[j]);
                            *(u32x2*)(dst + row * DM + col) = pack4(v);
                        }
                    }
            }
    }
};

template <class Epi, class Sched>
__device__ __forceinline__ void gemm_phase(LAS unsigned char* lds, const bf16_t* Ap, const bf16_t* Btp, const int K, const size_t ldaB, const Sched& S, const Epi& E) {
    int tid = threadIdx.x; asm volatile("" : "+v"(tid));
    const int wid = __builtin_amdgcn_readfirstlane(tid >> 6), lane = tid & 63, wr = wid >> 2, wc = wid & 3, fr = lane & 15, fq = lane >> 4;
    const int nt = K / BK;
    unsigned voffA[2], voffB[2];
#pragma unroll
    for (int i = 0; i < 2; ++i) { int R, C; stage_rc(tid * 16 + i * 8192, R, C); voffA[i] = (unsigned)(R * (int)ldaB + C * 2); voffB[i] = (unsigned)(R * K + C) * 2u; }
    const size_t kstep = (size_t)(BK * 2);
    const size_t hA = (size_t)HALF * ldaB, hB = (size_t)HALF * K * 2;
    const unsigned ldsw = (unsigned)wid * 1024u;
    const int aoff = lds_byte(wr * 64 + fr, fq * 8), boff = lds_byte(wc * 32 + fr, fq * 8);
#define G_SA(b, h) (((b) * 2 + (h)) * HTB)
#define G_SB(b, h) ((4 + (b) * 2 + (h)) * HTB)
#define G_STAGE(bufoff, gbase, voff) do { _Pragma("unroll") for (int _i = 0; _i < 2; ++_i) \
        __builtin_amdgcn_global_load_lds((const unsigned*)((const char*)(gbase) + (voff)[_i]), (LAS unsigned*)(lds + (bufoff) + ldsw + _i * 8192), 16, 0, 0); } while (0)
#define G_LDA(dst, b, h) do { _Pragma("unroll") for (int m = 0; m < 4; ++m) _Pragma("unroll") for (int k = 0; k < 2; ++k) dst[m][k] = *(const LAS bf16x8*)(lds + G_SA(b, h) + aoff + m * 2048 + k * 1024); } while (0)
#define G_LDB(dst, b, h) do { _Pragma("unroll") for (int n = 0; n < 2; ++n) _Pragma("unroll") for (int k = 0; k < 2; ++k) dst[n][k] = *(const LAS bf16x8*)(lds + G_SB(b, h) + boff + n * 2048 + k * 1024); } while (0)
#define G_MMA(ai, bj, At, Bt) do { __builtin_amdgcn_s_setprio(1); _Pragma("unroll") for (int m = 0; m < 4; ++m) _Pragma("unroll") for (int n = 0; n < 2; ++n) _Pragma("unroll") for (int k = 0; k < 2; ++k) \
        acc[ai][bj][m][n] = __builtin_amdgcn_mfma_f32_16x16x32_bf16(Bt[n][k], At[m][k], acc[ai][bj][m][n], 0, 0, 0); __builtin_amdgcn_s_setprio(0); } while (0)
#define G_WAIT_V(n) asm volatile("s_waitcnt vmcnt(" #n ")" ::: "memory")
#define G_WAIT_L(n) asm volatile("s_waitcnt lgkmcnt(" #n ")" ::: "memory")
#define G_BAR __builtin_amdgcn_s_barrier()
#define G_SCHED __builtin_amdgcn_sched_barrier(0)
    Unit cur, nxt; int ui = 0;
    if (!S.next(0, cur)) return;
    f32x4 acc[2][2][4][2];
#pragma unroll
    for (int a = 0; a < 2; ++a)
#pragma unroll
        for (int b = 0; b < 2; ++b)
#pragma unroll
            for (int m = 0; m < 4; ++m)
#pragma unroll
                for (int n = 0; n < 2; ++n) acc[a][b][m][n] = (f32x4){0.f, 0.f, 0.f, 0.f};
    bf16x8 At[4][2], B0[2][2], B1[2][2];
    const char* cA = (const char*)Ap + cur.aoff; const char* cB = (const char*)Btp + cur.boff;
    G_STAGE(G_SB(0, 0), cB, voffB); G_STAGE(G_SA(0, 0), cA, voffA); G_STAGE(G_SB(0, 1), cB + hB, voffB); G_STAGE(G_SA(0, 1), cA + hA, voffA);
    if (wr == 1) G_BAR;
    G_WAIT_V(4); G_BAR;
    G_STAGE(G_SB(1, 0), cB + kstep, voffB); G_STAGE(G_SA(1, 0), cA + kstep, voffA); G_STAGE(G_SB(1, 1), cB + hB + kstep, voffB);
    G_WAIT_V(6); G_BAR;
    for (;;) {
        const bool has_next = S.next(ui + 1, nxt);
        const char* nA = has_next ? (const char*)Ap + nxt.aoff : cA; const char* nB = has_next ? (const char*)Btp + nxt.boff : cB;
        for (int t = 0; t < nt; t += 2) {
            const bool last = (t == nt - 2);
            const char* a1 = cA + (size_t)(t + 1) * kstep;
            const char* a2 = last ? nA : cA + (size_t)(t + 2) * kstep; const char* b2 = last ? nB : cB + (size_t)(t + 2) * kstep;
            const char* a3 = a2 + kstep; const char* b3 = b2 + kstep;
            G_LDB(B0, 0, 0); G_SCHED; G_LDA(At, 0, 0); G_STAGE(G_SA(1, 1), a1 + hA, voffA);
            G_WAIT_L(8); G_BAR; G_WAIT_L(0); G_MMA(0, 0, At, B0); G_BAR; G_SCHED;
            G_LDB(B1, 0, 1); G_STAGE(G_SB(0, 0), b2, voffB);
            G_BAR; G_WAIT_L(0); G_MMA(0, 1, At, B1); G_BAR;
            G_LDA(At, 0, 1); G_STAGE(G_SA(0, 0), a2, voffA);
            G_BAR; G_WAIT_L(0); G_MMA(1, 0, At, B0); G_BAR; G_SCHED;
            G_STAGE(G_SB(0, 1), b2 + hB, voffB);
            G_WAIT_V(6); G_BAR; G_MMA(1, 1, At, B1); G_BAR;
            G_LDB(B0, 1, 0); G_SCHED; G_LDA(At, 1, 0); G_STAGE(G_SA(0, 1), a2 + hA, voffA);
            G_WAIT_L(8); G_BAR; G_WAIT_L(0); G_MMA(0, 0, At, B0); G_BAR; G_SCHED;
            G_LDB(B1, 1, 1); G_STAGE(G_SB(1, 0), b3, voffB);
            G_BAR; G_WAIT_L(0); G_MMA(0, 1, At, B1); G_BAR;
            G_LDA(At, 1, 1); G_STAGE(G_SA(1, 0), a3, voffA);
            G_BAR; G_WAIT_L(0); G_MMA(1, 0, At, B0); G_BAR; G_SCHED;
            G_STAGE(G_SB(1, 1), b3 + hB, voffB);
            G_WAIT_V(6); G_BAR; G_MMA(1, 1, At, B1); G_BAR;
        }
        E(acc, cur, wr, wc, fr, fq);
        if (!has_next) break;
#pragma unroll
        for (int a = 0; a < 2; ++a)
#pragma unroll
            for (int b = 0; b < 2; ++b)
#pragma unroll
                for (int m = 0; m < 4; ++m)
#pragma unroll
                    for (int n = 0; n < 2; ++n) acc[a][b][m][n] = (f32x4){0.f, 0.f, 0.f, 0.f};
        cur = nxt; cA = nA; cB = nB; ++ui;
    }
    G_WAIT_V(0);
    if (wr == 0) G_BAR;
    G_BAR;
#undef G_SA
#undef G_SB
#undef G_STAGE
#undef G_LDA
#undef G_LDB
#undef G_MMA
#undef G_WAIT_V
#undef G_WAIT_L
#undef G_BAR
#undef G_SCHED
}

__device__ __forceinline__ float wsrc(const Args& a, int mat, int n, int k) {
    switch (mat) {
    case 0: { const int g = n >> 10, c = n & 1023; return a.in[14][((size_t)g * 1024 + k) * 1024 + c]; }
    case 1: { const float* W; int col, ld, mi; const int nn = n & 255;
        if (nn < 64) { W = a.in[16]; col = nn; ld = 64; mi = 1; } else if (nn < 128) { W = a.in[19]; col = nn - 64; ld = 64; mi = 4; } else { W = a.in[21]; col = nn - 128; ld = 128; mi = 5; }
        const float mu = a.in[13][mi * 1024 + k]; const float w = W[(size_t)k * ld + col];
        return (n >= 256) ? mu * w : (1.0f - mu) * w; }
    case 2: {
        if (n < 1024) return (k < 64) ? a.in[17][(size_t)k * 1024 + n] : 0.f;
        if (n < 2048) return (k >= 64 && k < 128) ? a.in[20][(size_t)(k - 64) * 1024 + (n - 1024)] : 0.f;
        return (k >= 128) ? a.in[22][(size_t)(k - 128) * 1024 + (n - 2048)] : 0.f; }
    case 3: return a.in[28][(size_t)k * 1024 + n];
    case 4: case 8: { const int l = (mat == 4) ? 1 : 0; const int pn = n >> 8, r = n & 255; const int col = (r < 128) ? 128 * pn + r : FH + 128 * pn + r - 128;
        return a.in[29][(size_t)l * 1024 * 2 * FH + (size_t)k * 2 * FH + col]; }
    case 5: case 9: { const int l = (mat == 5) ? 1 : 0; return a.in[30][(size_t)l * FH * 1024 + (size_t)k * 1024 + n]; }
    case 6: { const int pn = n >> 8, r = n & 255; const int col = (pn < 4) ? ((r < 128) ? 128 * pn + r : 512 + 128 * pn + r - 128) : n; return a.in[1][(size_t)k * 2048 + col]; }
    default: return a.in[11][(size_t)k * 1024 + n];
    }
}
__device__ void prep_phase(const Args& a, LAS unsigned char* lds) {
    LAS float* tile = (LAS float*)lds;
    const int tid0 = tid_opaque(); const int tx = tid0 & 63, ty = tid0 >> 6;
    constexpr int T0 = 768, T1 = T0 + 128, T2 = T1 + 192, T3 = T2 + 256, T4 = T3 + 1408, T5 = T4 + 704, T6 = T5 + 512, T7 = T6 + 256, T8 = T7 + 1408, T9 = T8 + 704;
    for (int t = blockIdx.x; t < T9; t += gridDim.x) {
        int mat, lt, kt; size_t doff; int Kd;
        if (t < T0) { mat = 0; lt = t; kt = 16; doff = O_WRKV; Kd = 1024; }
        else if (t < T1) { mat = 1; lt = t - T0; kt = 16; doff = O_WL1; Kd = 1024; }
        else if (t < T2) { mat = 2; lt = t - T1; kt = 4; doff = O_L2T; Kd = 256; }
        else if (t < T3) { mat = 3; lt = t - T2; kt = 16; doff = O_WOT; Kd = 1024; }
        else if (t < T4) { mat = 4; lt = t - T3; kt = 16; doff = O_F1T1; Kd = 1024; }
        else if (t < T5) { mat = 5; lt = t - T4; kt = 44; doff = O_F2T1; Kd = FH; }
        else if (t < T6) { mat = 6; lt = t - T5; kt = 16; doff = O_W1T; Kd = 1024; }
        else if (t < T7) { mat = 7; lt = t - T6; kt = 16; doff = O_W2T; Kd = 1024; }
        else if (t < T8) { mat = 8; lt = t - T7; kt = 16; doff = O_F1T0; Kd = 1024; }
        else { mat = 9; lt = t - T8; kt = 44; doff = O_F2T0; Kd = FH; }
        const int n0 = (lt / kt) * 64, k0 = (lt % kt) * 64;
#pragma unroll
        for (int i = 0; i < 8; ++i) { const int kk = ty + 8 * i; tile[kk * 65 + tx] = wsrc(a, mat, n0 + tx, k0 + kk); }
        __syncthreads();
        bf16_t* dst = (bf16_t*)(a.ws + doff);
#pragma unroll
        for (int i = 0; i < 8; ++i) { const int nn = ty + 8 * i; dst[(size_t)(n0 + nn) * Kd + k0 + tx] = f2bf(tile[tx * 65 + nn]); }
        __syncthreads();
    }
    const float* x = a.in[0]; bf16_t* xb = (bf16_t*)(a.ws + SLOTP(0));
    for (size_t i = (size_t)blockIdx.x * 512 + tid0; i < (size_t)MT * DM / 4; i += (size_t)gridDim.x * 512) {
        const f32x4 v = *(const f32x4*)(x + 4 * i); *(u32x2*)(xb + 4 * i) = pack4(v);
    }
}

__device__ void conv_tile(const Args& a, LAS unsigned char* lds, int tile) {
    LAS bf16_t* in = (LAS bf16_t*)lds;
    LAS float* outf = (LAS float*)(lds + 63488);
    const bf16_t* ypre = (const bf16_t*)(a.ws + SLOTP(1));
    bf16_t* mixed = (bf16_t*)(a.ws + SLOTP(3));
    const int tid = tid_opaque(), wid = tid >> 6, lane = tid & 63;
    const int m0 = tile * 32, s0 = m0 & (SEQL - 1);
    for (int v = tid; v < 62 * 64; v += 512) {
        const int r = v >> 6, cv = v & 63; u32x4 val = (u32x4){0u, 0u, 0u, 0u};
        if (s0 - 30 + r >= 0) val = *(const u32x4*)(ypre + (size_t)(m0 - 30 + r) * 512 + cv * 8);
        *(LAS u32x4*)(in + r * 512 + cv * 8) = val;
    }
    __syncthreads();
    {
        const int c = tid; const float* cwp = a.in[3]; float cw[31];
#pragma unroll
        for (int w = 0; w < 31; ++w) cw[w] = cwp[w * 512 + c];
        const float cb = a.in[4][c];
        float xin[62];
#pragma unroll
        for (int r = 0; r < 62; ++r) xin[r] = bf2f(in[r * 512 + c]);
#pragma unroll
        for (int tt = 0; tt < 32; ++tt) { float s = cb;
#pragma unroll
            for (int w = 0; w < 31; ++w) s += xin[tt + w] * cw[w];
            outf[tt * 512 + c] = s; }
    }
    __syncthreads();
    {
        const float* g = a.in[5]; const float* b = a.in[6];
        const f32x4 g0 = *(const f32x4*)(g + 4 * lane), g1 = *(const f32x4*)(g + 256 + 4 * lane), b0 = *(const f32x4*)(b + 4 * lane), b1 = *(const f32x4*)(b + 256 + 4 * lane);
        for (int tt = wid; tt < 32; tt += 8) {
            f32x4 v0 = *(const LAS f32x4*)(outf + tt * 512 + 4 * lane), v1 = *(const LAS f32x4*)(outf + tt * 512 + 256 + 4 * lane);
            float s = (v0[0] + v0[1]) + (v0[2] + v0[3]) + (v1[0] + v1[1]) + (v1[2] + v1[3]);
            const float mean = wave_sum(s) * (1.0f / 512.0f);
            v0 -= mean; v1 -= mean;
            float q = v0[0] * v0[0] + v0[1] * v0[1] + v0[2] * v0[2] + v0[3] * v0[3] + v1[0] * v1[0] + v1[1] * v1[1] + v1[2] * v1[2] + v1[3] * v1[3];
            const float rstd = rsqrtf(wave_sum(q) * (1.0f / 512.0f) + 1e-5f);
            v0 = v0 * rstd * g0 + b0; v1 = v1 * rstd * g1 + b1;
#pragma unroll
            for (int j = 0; j < 4; ++j) { v0[j] = v0[j] * sigmoidf_(v0[j]); v1[j] = v1[j] * sigmoidf_(v1[j]); }
            bf16_t* o = mixed + (size_t)(m0 + tt) * DM;
            *(u32x2*)(o + 4 * lane) = pack4(v0); *(u32x2*)(o + 256 + 4 * lane) = pack4(v1);
        }
    }
    __syncthreads();
}
__device__ void sgu_item(const Args& a, LAS unsigned char* lds, int item) {
    LAS bf16_t* Wl = (LAS bf16_t*)lds;
    LAS bf16_t* VT = (LAS bf16_t*)(lds + 34816);
    LAS float* st = (LAS float*)(lds + 69632);
    const bf16_t* ug = (const bf16_t*)(a.ws + SLOTP(1) + 16 * MiB);
    const bf16_t* vg = (const bf16_t*)(a.ws + SLOTP(2));
    bf16_t* mixed = (bf16_t*)(a.ws + SLOTP(3));
    const int tid = tid_opaque(), wid = tid >> 6, lane = tid & 63;
    const int g = item & 3, m0 = (item >> 2) * 128;
    for (int i = 0; i < 16; ++i) {
        const int tok = 16 * wid + i; float f[8]; unpack8(*(const u32x4*)(vg + (size_t)(m0 + tok) * 512 + lane * 8), f);
        float s = 0.f;
#pragma unroll
        for (int e = 0; e < 8; ++e) s += f[e];
        const float mean = wave_sum(s) * (1.0f / 512.0f); float q = 0.f;
#pragma unroll
        for (int e = 0; e < 8; ++e) { const float d = f[e] - mean; q += d * d; }
        const float rstd = rsqrtf(wave_sum(q) * (1.0f / 512.0f) + 1e-5f);
        if (lane == 0) { st[2 * tok] = mean; st[2 * tok + 1] = rstd; }
    }
    __syncthreads();
    {
        const int s = tid & 127, dq = tid >> 7; const float mean = st[2 * s], rstd = st[2 * s + 1];
        const float* sg = a.in[7] + g * 128; const float* sb = a.in[8] + g * 128;
#pragma unroll
        for (int i = 0; i < 4; ++i) {
            const int d0 = (dq * 4 + i) * 8; float f[8]; unpack8(*(const u32x4*)(vg + (size_t)(m0 + s) * 512 + g * 128 + d0), f);
#pragma unroll
            for (int e = 0; e < 8; ++e) VT[(d0 + e) * 136 + s] = f2bf((f[e] - mean) * rstd * sg[d0 + e] + sb[d0 + e]);
        }
        const float* W = a.in[9] + (size_t)g * 128 * 128;
        for (int idx = tid; idx < 128 * 32; idx += 512) {
            const int t = idx >> 5, s4 = (idx & 31) * 4; f32x4 w = *(const f32x4*)(W + t * 128 + s4);
#pragma unroll
            for (int e = 0; e < 4; ++e) if (s4 + e > t) w[e] = 0.f;
            *(LAS u32x2*)(Wl + t * 136 + s4) = pack4(w);
        }
    }
    __syncthreads();
    {
        const int t0 = 16 * wid, row = lane & 15, quad = lane >> 4;
        f32x4 acc[8];
#pragma unroll
        for (int db = 0; db < 8; ++db) acc[db] = (f32x4){0.f, 0.f, 0.f, 0.f};
        for (int s0 = 0; s0 < t0 + 16; s0 += 32) {
            const bf16x8 av = *(const LAS bf16x8*)(Wl + (t0 + row) * 136 + s0 + quad * 8);
#pragma unroll
            for (int db = 0; db < 8; ++db) { const bf16x8 bv = *(const LAS bf16x8*)(VT + (db * 16 + row) * 136 + s0 + quad * 8);
                acc[db] = __builtin_amdgcn_mfma_f32_16x16x32_bf16(av, bv, acc[db], 0, 0, 0); }
        }
        const float* sbias = a.in[10] + g * 128;
#pragma unroll
        for (int db = 0; db < 8; ++db)
#pragma unroll
            for (int j = 0; j < 4; ++j) {
                const int t = t0 + quad * 4 + j, d = db * 16 + row; const float sv = acc[db][j] + sbias[t];
                const float uv = bf2f(ug[(size_t)(m0 + t) * 512 + g * 128 + d]);
                mixed[(size_t)(m0 + t) * DM + 512 + g * 128 + d] = f2bf(uv * sv);
            }
    }
    __syncthreads();
}

struct Row16 { f32x4 v[4]; };
__device__ __forceinline__ void row_load(const float* p, int lane, Row16& r) {
#pragma unroll
    for (int i = 0; i < 4; ++i) r.v[i] = *(const f32x4*)(p + 256 * i + 4 * lane);
}
__device__ __forceinline__ void row_ln(Row16& r, const Row16& g, const Row16& b) {
    float s = 0.f;
#pragma unroll
    for (int i = 0; i < 4; ++i) s += (r.v[i][0] + r.v[i][1]) + (r.v[i][2] + r.v[i][3]);
    const float mean = wave_sum(s) * (1.0f / 1024.0f); float q = 0.f;
#pragma unroll
    for (int i = 0; i < 4; ++i) { r.v[i] -= mean; q += r.v[i][0] * r.v[i][0] + r.v[i][1] * r.v[i][1] + r.v[i][2] * r.v[i][2] + r.v[i][3] * r.v[i][3]; }
    const float rstd = rsqrtf(wave_sum(q) * (1.0f / 1024.0f) + 1e-5f);
#pragma unroll
    for (int i = 0; i < 4; ++i) r.v[i] = r.v[i] * rstd * g.v[i] + b.v[i];
}
__device__ __forceinline__ void row_store_bf(bf16_t* p, int lane, const Row16& r) {
#pragma unroll
    for (int i = 0; i < 4; ++i) *(u32x2*)(p + 256 * i + 4 * lane) = pack4(r.v[i]);
}
__device__ void ln_phase(const float* src, float* dstf, bf16_t* dstb, const float* gp, const float* bp) {
    const int tid = tid_opaque(); const int lane = tid & 63, gw = blockIdx.x * 8 + (tid >> 6), nw = gridDim.x * 8;
    Row16 g, b; row_load(gp, lane, g); row_load(bp, lane, b);
    for (int row = gw; row < MT; row += nw) {
        Row16 r; row_load(src + (size_t)row * DM, lane, r); row_ln(r, g, b);
#pragma unroll
        for (int i = 0; i < 4; ++i) *(f32x4*)(dstf + (size_t)row * DM + 256 * i + 4 * lane) = r.v[i];
        if (dstb) row_store_bf(dstb + (size_t)row * DM, lane, r);
    }
}
__device__ void ln_shift_phase(const Args& a) {
    const float* src = (const float*)(a.ws + SLOTP(4)); float* xf = a.out;
    bf16_t* xr = (bf16_t*)(a.ws + SLOTP(0)); bf16_t* xk = (bf16_t*)(a.ws + SLOTP(1)); bf16_t* xv = (bf16_t*)(a.ws + SLOTP(2)); bf16_t* xg = (bf16_t*)(a.ws + SLOTP(3));
    const int tid = tid_opaque(); const int lane = tid & 63, gw = blockIdx.x * 8 + (tid >> 6), nw = gridDim.x * 8;
    Row16 g, b, mr, mk, mv; row_load(a.in[33], lane, g); row_load(a.in[34], lane, b);
    row_load(a.in[13], lane, mr); row_load(a.in[13] + 2 * 1024, lane, mk); row_load(a.in[13] + 3 * 1024, lane, mv);
    for (int ch = gw; ch < MT / 8; ch += nw) {
        const int r0 = ch * 8; Row16 prev;
        if ((r0 & (SEQL - 1)) == 0) {
#pragma unroll
            for (int i = 0; i < 4; ++i) prev.v[i] = (f32x4){0.f, 0.f, 0.f, 0.f};
        } else { row_load(src + (size_t)(r0 - 1) * DM, lane, prev); row_ln(prev, g, b); }
        for (int r = r0; r < r0 + 8; ++r) {
            Row16 cur; row_load(src + (size_t)r * DM, lane, cur); row_ln(cur, g, b);
#pragma unroll
            for (int i = 0; i < 4; ++i) *(f32x4*)(xf + (size_t)r * DM + 256 * i + 4 * lane) = cur.v[i];
            row_store_bf(xg + (size_t)r * DM, lane, cur);
            Row16 t;
#pragma unroll
            for (int i = 0; i < 4; ++i) t.v[i] = cur.v[i] + (prev.v[i] - cur.v[i]) * mr.v[i];
            row_store_bf(xr + (size_t)r * DM, lane, t);
#pragma unroll
            for (int i = 0; i < 4; ++i) t.v[i] = cur.v[i] + (prev.v[i] - cur.v[i]) * mk.v[i];
            row_store_bf(xk + (size_t)r * DM, lane, t);
#pragma unroll
            for (int i = 0; i < 4; ++i) t.v[i] = cur.v[i] + (prev.v[i] - cur.v[i]) * mv.v[i];
            row_store_bf(xv + (size_t)r * DM, lane, t);
            prev = cur;
        }
    }
}

__device__ void hid_phase(const Args& a) {
    const bf16_t* pq = (const bf16_t*)(a.ws + O_W1T); bf16_t* hid = (bf16_t*)(a.ws + O_HID);
    const int t0 = tid_opaque();
    for (int idx = blockIdx.x * 512 + t0; idx < MT * 64; idx += gridDim.x * 512) {
        const int m = idx >> 6, c4 = (idx & 63) * 4;
        const u32x2 q = *(const u32x2*)(pq + (size_t)m * 512 + c4);
        u32x2 p = (u32x2){0u, 0u}; if (m & (SEQL - 1)) p = *(const u32x2*)(pq + (size_t)(m - 1) * 512 + 256 + c4);
        f32x4 v; v[0] = __uint_as_float(q.x << 16) + __uint_as_float(p.x << 16); v[1] = __uint_as_float(q.x & 0xffff0000u) + __uint_as_float(p.x & 0xffff0000u);
        v[2] = __uint_as_float(q.y << 16) + __uint_as_float(p.y << 16); v[3] = __uint_as_float(q.y & 0xffff0000u) + __uint_as_float(p.y & 0xffff0000u);
        if (c4 < 64) {
#pragma unroll
            for (int j = 0; j < 4; ++j) v[j] = 2.0f * sigmoidf_(2.0f * v[j]) - 1.0f;
        } else if (c4 >= 128) {
#pragma unroll
            for (int j = 0; j < 4; ++j) v[j] = sigmoidf_(v[j]);
        }
        *(u32x2*)(hid + (size_t)m * 256 + c4) = pack4(v);
    }
}

constexpr int TC = 32, SBUF = (5 * TC * 64 + TC * 16) * 4;
__device__ void scan_phase(const Args& a, LAS unsigned char* lds) {
    const bf16_t* rp = (const bf16_t*)(a.ws + SLOTP(4)); const bf16_t* kp = (const bf16_t*)(a.ws + SLOTP(5)); const bf16_t* vp = (const bf16_t*)(a.ws + SLOTP(0));
    const bf16_t* ep = (const bf16_t*)(a.ws + SLOTP(1)); const bf16_t* ap = (const bf16_t*)(a.ws + SLOTP(2));
    bf16_t* yraw = (bf16_t*)(a.ws + SLOTP(3)); float* ct = (float*)(a.ws + O_CT);
    const int tid = tid_opaque(), wid = tid >> 6, lane = tid & 63;
    for (int item = blockIdx.x; item < 256; item += gridDim.x) {
        const int xcd = item & 7, slot = item >> 3, hg = xcd * 8 + (slot >> 2), q = slot & 3, bb = hg >> 4, h = hg & 15;
        const size_t mbase = (size_t)bb * SEQL;
        const int col = h * 64 + lane;
        const float kkc = a.in[23][col], kac = a.in[24][col], rkc = a.in[25][col];
        auto stage = [&](int c, int bufi) {
            LAS float* B = (LAS float*)(lds + bufi * SBUF);
            const int sw = wid - 4;
            float rr[8], kk[8], vv[8], ee[8], aa[8];
#pragma unroll
            for (int i = 0; i < 8; ++i) { const size_t idx = (mbase + c * TC + sw * 8 + i) * DM + col;
                rr[i] = bf2f(rp[idx]); kk[i] = bf2f(kp[idx]); vv[i] = bf2f(vp[idx]); ee[i] = bf2f(ep[idx]); aa[i] = bf2f(ap[idx]); }
#pragma unroll
            for (int i = 0; i < 8; ++i) {
                const int tl = sw * 8 + i;
                const float kkr = kk[i] * kkc; const float ss = wave_sum(kkr * kkr); const float inv = 1.0f / fmaxf(sqrtf(ss), 1e-12f);
                const float nkk = -kkr * inv; const float kpr = kk[i] * (1.0f + (aa[i] - 1.0f) * kac);
                const float cterm = wave_sum(rr[i] * kpr * rkc);
                B[0 * TC * 64 + tl * 64 + lane] = __expf(-ee[i]);
                B[1 * TC * 64 + tl * 64 + lane] = nkk;
                B[2 * TC * 64 + tl * 64 + lane] = -nkk * aa[i];
                B[3 * TC * 64 + tl * 64 + lane] = kpr;
                B[4 * TC * 64 + tl * 64 + lane] = rr[i];
                if ((lane >> 4) == q) B[5 * TC * 64 + tl * 16 + (lane & 15)] = vv[i];
                if (q == 0 && lane == 0) ct[(mbase + c * TC + tl) * 16 + h] = cterm;
            }
        };
        if (wid >= 4) stage(0, 0);
        __syncthreads();
        f32x4 S = (f32x4){0.f, 0.f, 0.f, 0.f};
        const int il = lane >> 4, jl = lane & 15, rowl = 4 * (wid & 3) + il;
        for (int c = 0; c < SEQL / TC; ++c) {
            if (wid >= 4) { if (c + 1 < SEQL / TC) stage(c + 1, (c + 1) & 1); }
            else {
                const LAS float* B = (const LAS float*)(lds + (c & 1) * SBUF);
                bf16_t* yo = yraw + (mbase + c * TC) * DM + h * 64 + 16 * q + rowl;
#pragma unroll 4
                for (int tl = 0; tl < TC; ++tl) {
                    const f32x4 w4 = *(const LAS f32x4*)(B + 0 * TC * 64 + tl * 64 + 4 * jl), n4 = *(const LAS f32x4*)(B + 1 * TC * 64 + tl * 64 + 4 * jl),
                                b4 = *(const LAS f32x4*)(B + 2 * TC * 64 + tl * 64 + 4 * jl), k4 = *(const LAS f32x4*)(B + 3 * TC * 64 + tl * 64 + 4 * jl),
                                r4 = *(const LAS f32x4*)(B + 4 * TC * 64 + tl * 64 + 4 * jl);
                    const float vi = B[5 * TC * 64 + tl * 16 + rowl];
                    float sa = (S[0] * n4[0] + S[1] * n4[1]) + (S[2] * n4[2] + S[3] * n4[3]);
                    sa += __shfl_xor(sa, 1); sa += __shfl_xor(sa, 2); sa += __shfl_xor(sa, 4); sa += __shfl_xor(sa, 8);
                    S = S * w4 + k4 * vi + b4 * sa;
                    float y = (S[0] * r4[0] + S[1] * r4[1]) + (S[2] * r4[2] + S[3] * r4[3]);
                    y += __shfl_xor(y, 1); y += __shfl_xor(y, 2); y += __shfl_xor(y, 4); y += __shfl_xor(y, 8);
                    if (jl == 0) yo[(size_t)tl * DM] = f2bf(y);
                }
            }
            __syncthreads();
        }
    }
}
__device__ void post_phase(const Args& a) {
    const bf16_t* yraw = (const bf16_t*)(a.ws + SLOTP(3)); const bf16_t* vp = (const bf16_t*)(a.ws + SLOTP(0)); const bf16_t* gg = (const bf16_t*)(a.ws + SLOTP(4));
    const float* ct = (const float*)(a.ws + O_CT); bf16_t* yb = (bf16_t*)(a.ws + SLOTP(5));
    const int tid = tid_opaque(); const int lane = tid & 63, gw = blockIdx.x * 8 + (tid >> 6), nw = gridDim.x * 8;
    const int c0 = 16 * lane;
    float lg[16], lb[16];
#pragma unroll
    for (int i = 0; i < 16; ++i) { lg[i] = a.in[26][c0 + i]; lb[i] = a.in[27][c0 + i]; }
    for (int row = gw; row < MT; row += nw) {
        const size_t o = (size_t)row * DM + c0; float y[16], v[16], g[16];
        unpack8(*(const u32x4*)(yraw + o), *(float(*)[8])&y[0]); unpack8(*(const u32x4*)(yraw + o + 8), *(float(*)[8])&y[8]);
        unpack8(*(const u32x4*)(vp + o), *(float(*)[8])&v[0]); unpack8(*(const u32x4*)(vp + o + 8), *(float(*)[8])&v[8]);
        unpack8(*(const u32x4*)(gg + o), *(float(*)[8])&g[0]); unpack8(*(const u32x4*)(gg + o + 8), *(float(*)[8])&g[8]);
        const float cv = ct[(size_t)row * 16 + (lane >> 2)];
        float s = 0.f;
#pragma unroll
        for (int i = 0; i < 16; ++i) s += y[i];
        s += __shfl_xor(s, 1); s += __shfl_xor(s, 2);
        const float mean = s * (1.0f / 64.0f); float qq = 0.f;
#pragma unroll
        for (int i = 0; i < 16; ++i) { y[i] -= mean; qq += y[i] * y[i]; }
        qq += __shfl_xor(qq, 1); qq += __shfl_xor(qq, 2);
        const float rstd = rsqrtf(qq * (1.0f / 64.0f) + 64e-5f);
        u32x4 w0, w1; float of[16];
#pragma unroll
        for (int i = 0; i < 16; ++i) of[i] = (y[i] * rstd * lg[i] + lb[i] + cv * v[i]) * g[i];
#pragma unroll
        for (int i = 0; i < 4; ++i) { w0[i] = cvt_pk_bf16(of[2 * i], of[2 * i + 1]); w1[i] = cvt_pk_bf16(of[8 + 2 * i], of[8 + 2 * i + 1]); }
        *(u32x4*)(yb + o) = w0; *(u32x4*)(yb + o + 8) = w1;
    }
}

constexpr int NPHASE = 19;
__global__ void __launch_bounds__(512, 2) mk_fwd(Args a) {
    extern __shared__ __attribute__((aligned(16))) unsigned char smem[];
    LAS unsigned char* lds = (LAS unsigned char*)smem;
    cg::grid_group grid = cg::this_grid();
    unsigned char* ws = a.ws;
#define BFP(off) ((bf16_t*)(ws + (off)))
    if (a.ph_lo <= 0 && 0 < a.ph_hi) { if (ONLY < 0 || ONLY == 0) { prep_phase(a, lds); }
        if (0 + 1 < a.ph_hi) grid.sync(); }
    if (a.ph_lo <= 1 && 1 < a.ph_hi) { if (ONLY < 0 || ONLY == 1) { { StaticOrder S{64, 8, 2048, 2048}; EpiG1 E{BFP(SLOTP(1)), BFP(SLOTP(1) + 16 * MiB), BFP(SLOTP(2)), a.in[2]};
            gemm_phase(lds, BFP(SLOTP(0)), BFP(O_W1T), 1024, 2048, S, E); } }
        if (1 + 1 < a.ph_hi) grid.sync(); }
    if (a.ph_lo <= 2 && 2 < a.ph_hi) { if (ONLY < 0 || ONLY == 2) { { for (int t = blockIdx.x; t < 512; t += gridDim.x) conv_tile(a, lds, t);
            for (int t = blockIdx.x; t < 512; t += gridDim.x) sgu_item(a, lds, t); } }
        if (2 + 1 < a.ph_hi) grid.sync(); }
    if (a.ph_lo <= 3 && 3 < a.ph_hi) { if (ONLY < 0 || ONLY == 3) { { StaticOrder S{64, 4, 2048, 2048}; EpiRes E{a.in[0], a.out, a.in[12]}; gemm_phase(lds, BFP(SLOTP(3)), BFP(O_W2T), 1024, 2048, S, E); } }
        if (3 + 1 < a.ph_hi) grid.sync(); }
    if (a.ph_lo <= 4 && 4 < a.ph_hi) { if (ONLY < 0 || ONLY == 4) { ln_phase(a.out, a.out, BFP(SLOTP(0)), a.in[31], a.in[32]); }
        if (4 + 1 < a.ph_hi) grid.sync(); }
    if (a.ph_lo <= 5 && 5 < a.ph_hi) { if (ONLY < 0 || ONLY == 5) { { StaticOrder S{64, 22, 2048, 2048}; EpiSwiglu E{BFP(SLOTP(1))}; gemm_phase(lds, BFP(SLOTP(0)), BFP(O_F1T0), 1024, 2048, S, E); } }
        if (5 + 1 < a.ph_hi) grid.sync(); }
    if (a.ph_lo <= 6 && 6 < a.ph_hi) { if (ONLY < 0 || ONLY == 6) { { StaticOrder S{64, 4, 2 * FH, 2 * FH}; EpiRes E{a.out, (float*)(ws + SLOTP(4)), nullptr}; gemm_phase(lds, BFP(SLOTP(1)), BFP(O_F2T0), FH, 2 * FH, S, E); } }
        if (6 + 1 < a.ph_hi) grid.sync(); }
    if (a.ph_lo <= 7 && 7 < a.ph_hi) { if (ONLY < 0 || ONLY == 7) { ln_shift_phase(a); }
        if (7 + 1 < a.ph_hi) grid.sync(); }
    if (a.ph_lo <= 8 && 8 < a.ph_hi) { if (ONLY < 0 || ONLY == 8) { { StaticOrder S2{64, 2, 2048, 2048}; EpiBf<3> E2{BFP(O_W1T), nullptr, 0, nullptr, nullptr}; gemm_phase(lds, BFP(SLOTP(3)), BFP(O_WL1), 1024, 2048, S2, E2);
            GroupOrder S{2, SLOT}; EpiBf<0> E{BFP(SLOTP(4)), nullptr, SLOT / 2, nullptr, nullptr}; gemm_phase(lds, BFP(SLOTP(0)), BFP(O_WRKV), 1024, 2048, S, E); } }
        if (8 + 1 < a.ph_hi) grid.sync(); }
    if (a.ph_lo <= 9 && 9 < a.ph_hi) { if (ONLY < 0 || ONLY == 9) { { StaticOrder S{64, 4, 2048, 2048}; EpiBf<0> E{BFP(SLOTP(0)), nullptr, 0, nullptr, nullptr}; gemm_phase(lds, BFP(SLOTP(2)), BFP(O_WRKV + 4 * MiB), 1024, 2048, S, E); hid_phase(a); } }
        if (9 + 1 < a.ph_hi) grid.sync(); }
    if (a.ph_lo <= 10 && 10 < a.ph_hi) { if (ONLY < 0 || ONLY == 10) { { StaticOrder S{64, 4, 512, 512}; EpiBf<2> E{BFP(SLOTP(1)), nullptr, 0, a.in[15], nullptr}; gemm_phase(lds, BFP(O_HID), BFP(O_L2T), 256, 512, S, E);
            EpiBf<4> E2{BFP(SLOTP(2)), nullptr, 0, a.in[18], nullptr}; gemm_phase(lds, BFP(O_HID), BFP(O_L2T + 512 * 1024), 256, 512, S, E2); } }
        if (10 + 1 < a.ph_hi) grid.sync(); }
    if (a.ph_lo <= 11 && 11 < a.ph_hi) { if (ONLY < 0 || ONLY == 11) { scan_phase(a, lds); }
        if (11 + 1 < a.ph_hi) grid.sync(); }
    if (a.ph_lo <= 12 && 12 < a.ph_hi) { if (ONLY < 0 || ONLY == 12) { { StaticOrder S{64, 4, 512, 512}; EpiBf<0> E{BFP(SLOTP(4)), nullptr, 0, nullptr, nullptr}; gemm_phase(lds, BFP(O_HID), BFP(O_L2T + 1 * MiB), 256, 512, S, E); } }
        if (12 + 1 < a.ph_hi) grid.sync(); }
    if (a.ph_lo <= 13 && 13 < a.ph_hi) { if (ONLY < 0 || ONLY == 13) { post_phase(a); }
        if (13 + 1 < a.ph_hi) grid.sync(); }
    if (a.ph_lo <= 14 && 14 < a.ph_hi) { if (ONLY < 0 || ONLY == 14) { { StaticOrder S{64, 4, 2048, 2048}; EpiRes E{a.out, a.out, nullptr}; gemm_phase(lds, BFP(SLOTP(5)), BFP(O_WOT), 1024, 2048, S, E); } }
        if (14 + 1 < a.ph_hi) grid.sync(); }
    if (a.ph_lo <= 15 && 15 < a.ph_hi) { if (ONLY < 0 || ONLY == 15) { ln_phase(a.out, a.out, BFP(SLOTP(0)), a.in[31] + 1024, a.in[32] + 1024); }
        if (15 + 1 < a.ph_hi) grid.sync(); }
    if (a.ph_lo <= 16 && 16 < a.ph_hi) { if (ONLY < 0 || ONLY == 16) { { StaticOrder S{64, 22, 2048, 2048}; EpiSwiglu E{BFP(SLOTP(1))}; gemm_phase(lds, BFP(SLOTP(0)), BFP(O_F1T1), 1024, 2048, S, E); } }
        if (16 + 1 < a.ph_hi) grid.sync(); }
    if (a.ph_lo <= 17 && 17 < a.ph_hi) { if (ONLY < 0 || ONLY == 17) { { StaticOrder S{64, 4, 2 * FH, 2 * FH}; EpiRes E{a.out, a.out, nullptr}; gemm_phase(lds, BFP(SLOTP(1)), BFP(O_F2T1), FH, 2 * FH, S, E); } }
        if (17 + 1 < a.ph_hi) grid.sync(); }
    if (a.ph_lo <= 18 && 18 < a.ph_hi) { if (ONLY < 0 || ONLY == 18) { ln_phase(a.out, a.out, nullptr, a.in[33] + 1024, a.in[34] + 1024); }
        if (18 + 1 < a.ph_hi) grid.sync(); }
    if (a.ph_lo <= 19 && 19 < a.ph_hi) { const bf16_t* src = BFP(DUMP_OFF); const int t0 = tid_opaque();
        for (size_t i = (size_t)blockIdx.x * 512 + t0; i < (size_t)MT * DM; i += (size_t)gridDim.x * 512) a.out[i] = bf2f(src[i]); }
#undef BFP
}

extern "C" void kernel_launch(void* const* d_in, const int* in_sizes, int n_in, void* d_out, int out_size, void* d_ws, size_t ws_size, hipStream_t stream) {
    static int grid_blocks = 0;
    if (grid_blocks == 0) {
        if (n_in != 35 || out_size != MT * DM || ws_size < WS_END) { fprintf(stderr, "kernel_launch: unexpected shapes (n_in %d out %d ws %zu need %zu)\n", n_in, out_size, ws_size, (size_t)WS_END); grid_blocks = -1; return; }
        int dev = 0, cus = 0, per_cu = 0;
        hipGetDevice(&dev); hipDeviceGetAttribute(&cus, hipDeviceAttributeMultiprocessorCount, dev);
        hipFuncSetAttribute((const void*)mk_fwd, hipFuncAttributeMaxDynamicSharedMemorySize, STAGE_BYTES);
        hipOccupancyMaxActiveBlocksPerMultiprocessor(&per_cu, (const void*)mk_fwd, 512, STAGE_BYTES);
        if (per_cu < 1) per_cu = 1;
        grid_blocks = cus * per_cu;
        if (grid_blocks > 256) grid_blocks = 256;
    }
    if (grid_blocks < 0) return;
    Args a{};
    for (int i = 0; i < 35; ++i) a.in[i] = (const float*)d_in[i];
    a.out = (float*)d_out; a.ws = (unsigned char*)d_ws;
#if PER_PHASE_LAUNCH
    for (int ph = 0; ph < NPHASE && ph <= STOP_AFTER; ++ph) {
        a.ph_lo = ph; a.ph_hi = ph + 1; void* args[] = {&a};
        hipError_t e = hipLaunchCooperativeKernel((const void*)mk_fwd, dim3(grid_blocks), dim3(512), args, STAGE_BYTES, stream);
        if (e != hipSuccess) { fprintf(stderr, "cooperative launch failed: %s\n", hipGetErrorString(e)); return; }
    }
    if (STOP_AFTER < NPHASE - 1) { a.ph_lo = 19; a.ph_hi = 20; void* args[] = {&a};
        (void)hipLaunchCooperativeKernel((const void*)mk_fwd, dim3(grid_blocks), dim3(512), args, STAGE_BYTES, stream); }
#else
    a.ph_lo = 0; a.ph_hi = NPHASE; void* args[] = {&a};
    hipError_t e = hipLaunchCooperativeKernel((const void*)mk_fwd, dim3(grid_blocks), dim3(512), args, STAGE_BYTES, stream);
    if (e != hipSuccess) fprintf(stderr, "cooperative launch failed: %s (grid %d)\n", hipGetErrorString(e), grid_blocks);
#endif
}
```

```cpp
#include <hip/hip_runtime.h>
#include <hip/hip_cooperative_groups.h>
#include <cstdio>
namespace cg = cooperative_groups;

#ifndef PER_PHASE_LAUNCH
#define PER_PHASE_LAUNCH 0
#endif

#ifndef STOP_AFTER
#define STOP_AFTER 99
#endif
#ifndef DUMP_OFF
#define DUMP_OFF SLOTP(2)
#endif
#ifndef ONLY
#define ONLY -1
#endif
#define LAS __attribute__((address_space(3)))
typedef unsigned short bf16_t;
typedef short bf16x8 __attribute__((ext_vector_type(8)));
typedef float f32x4 __attribute__((ext_vector_type(4)));
typedef unsigned u32x4 __attribute__((ext_vector_type(4)));
typedef unsigned u32x2 __attribute__((ext_vector_type(2)));

constexpr int MT = 16384, DM = 1024, SEQL = 4096, FH = 2816;
constexpr float ALPHA = 1.41421356237f;
constexpr size_t MiB = 1ull << 20;
constexpr size_t O_WRKV = 0;
constexpr size_t O_WL1 = 6 * MiB;
constexpr size_t O_L2T = 7 * MiB;
constexpr size_t O_WOT = 8 * MiB + 512 * 1024;
constexpr size_t O_F1T1 = 10 * MiB + 512 * 1024;
constexpr size_t O_F2T1 = 21 * MiB + 512 * 1024;
constexpr size_t O_W1T = 27 * MiB;
constexpr size_t O_W2T = 31 * MiB;
constexpr size_t O_F1T0 = 33 * MiB;
constexpr size_t O_F2T0 = 44 * MiB;
constexpr size_t O_CT = 50 * MiB;
constexpr size_t O_SLOT = 52 * MiB;
constexpr size_t SLOT = 32 * MiB + 64 * 1024;
constexpr size_t O_HID = O_SLOT + 6 * SLOT;
constexpr size_t WS_END = O_HID + 8 * MiB;
#define SLOTP(i) (O_SLOT + (size_t)(i) * SLOT)

struct Args { const float* in[35]; float* out; unsigned char* ws; int ph_lo, ph_hi; };

__device__ __forceinline__ float bf2f(bf16_t v) { return __uint_as_float((unsigned)v << 16); }
typedef float f32x2 __attribute__((ext_vector_type(2)));
typedef __bf16 bf16x2n __attribute__((ext_vector_type(2)));
__device__ __forceinline__ unsigned cvt_pk_bf16(float lo, float hi) { const f32x2 v = {lo, hi}; return __builtin_bit_cast(unsigned, __builtin_convertvector(v, bf16x2n)); }
__device__ __forceinline__ bf16_t f2bf(float f) { return (bf16_t)(cvt_pk_bf16(f, 0.f) & 0xffffu); }
__device__ __forceinline__ float sigmoidf_(float z) { return __builtin_amdgcn_rcpf(1.0f + __expf(-z)); }
__device__ __forceinline__ float gelu_tanh(float x) { return x * sigmoidf_(1.5957691216f * (x + 0.044715f * x * x * x)); }
__device__ __forceinline__ int tid_opaque() { int t = threadIdx.x; asm volatile("" : "+v"(t)); return t; }
template <int CTRL> __device__ __forceinline__ float dpp_mov(float v) { return __int_as_float(__builtin_amdgcn_update_dpp(0, __float_as_int(v), CTRL, 0xF, 0xF, true)); }
__device__ __forceinline__ float red16(float v) { v += dpp_mov<0xB1>(v); v += dpp_mov<0x4E>(v); v += dpp_mov<0x141>(v); v += dpp_mov<0x140>(v); return v; }
__device__ __forceinline__ float wave_sum(float v) {
    v = red16(v);
    return ((__int_as_float(__builtin_amdgcn_readlane(__float_as_int(v), 0)) + __int_as_float(__builtin_amdgcn_readlane(__float_as_int(v), 16))) + (__int_as_float(__builtin_amdgcn_readlane(__float_as_int(v), 32)) + __int_as_float(__builtin_amdgcn_readlane(__float_as_int(v), 48))));
}
__device__ __forceinline__ float wave_sum_old(float v) {
#pragma unroll
    for (int o = 32; o; o >>= 1) v += __shfl_xor(v, o);
    return v;
}
__device__ __forceinline__ u32x2 pack4(f32x4 v) { u32x2 w; w.x = cvt_pk_bf16(v[0], v[1]); w.y = cvt_pk_bf16(v[2], v[3]); return w; }
__device__ __forceinline__ void unpack8(u32x4 r, float (&f)[8]) {
#pragma unroll
    for (int i = 0; i < 4; ++i) { f[2 * i] = __uint_as_float(r[i] << 16); f[2 * i + 1] = __uint_as_float(r[i] & 0xffff0000u); }
}

constexpr int BM = 256, BK = 64, HALF = 128, HTB = HALF * BK * 2, STAGE_BYTES = 8 * HTB, NXCD = 8, WGM = 8;
__device__ __forceinline__ int lds_byte(int r, int c) { const int st = (r >> 4) * 2 + (c >> 5), rr = r & 15, cc = c & 31, ob = rr * 64 + cc * 2; return st * 1024 + (ob ^ (((ob >> 9) & 1) << 5)); }
__device__ __forceinline__ void stage_rc(int b, int& R, int& C) { const int st = b / 1024, sb = b % 1024, swz = sb ^ (((sb >> 9) & 1) << 5); R = (st >> 1) * 16 + swz / 64; C = (st & 1) * 32 + (swz % 64) / 2; }

struct Unit { int pm, pn, tag; size_t aoff, boff; };
__device__ __forceinline__ void remap_tile(int wgid, int nM, int nN, int& pm, int& pn) {
    const int nwg = nM * nN;
    { const int q = nwg / NXCD, r = nwg % NXCD, xcd = wgid % NXCD, off = wgid / NXCD; wgid = (xcd < r ? xcd * (q + 1) : r * (q + 1) + (xcd - r) * q) + off; }
    const int nig = WGM * nN, gid = wgid / nig, fm = gid * WGM, gsz = (nM - fm) < WGM ? (nM - fm) : WGM;
    pm = fm + ((wgid % nig) % gsz); pn = (wgid % nig) / gsz;
}
struct StaticOrder {
    int nM, nN; size_t ldaB, ldbB;
    __device__ __forceinline__ bool next(int i, Unit& u) const {
        const long L = (long)i * gridDim.x + blockIdx.x; if (L >= (long)nM * nN) return false;
        remap_tile((int)L, nM, nN, u.pm, u.pn); u.tag = 0; u.aoff = (size_t)u.pm * BM * ldaB; u.boff = (size_t)u.pn * BM * ldbB; return true;
    }
};
struct GroupOrder {
    int ngr; size_t astride;
    __device__ __forceinline__ bool next(int i, Unit& u) const {
        const long L = (long)i * gridDim.x + blockIdx.x; if (L >= (long)ngr * 256) return false;
        const int g = (int)(L >> 8); remap_tile((int)(L & 255), 64, 4, u.pm, u.pn); u.tag = g;
        u.aoff = (size_t)g * astride + (size_t)u.pm * BM * 2048; u.boff = (size_t)(g * 4 + u.pn) * BM * 2048; return true;
    }
};
struct LoraOrder {
    __device__ __forceinline__ bool next(int i, Unit& u) const {
        const long L = (long)i * gridDim.x + blockIdx.x; if (L >= 64) return false;
        u.pm = (int)L; u.pn = 0; u.tag = 0; u.aoff = (size_t)(256 * u.pm + (u.pm >> 4)) * 2048; u.boff = 0; return true;
    }
};

#define EPI_ROWS(ai, m) (u.pm * BM + (ai) * HALF + wr * 64 + (m) * 16 + fr)
#define EPI_CL(n) (wc * 32 + (n) * 16 + 4 * fq)
typedef f32x4 AccT[2][2][4][2];

struct EpiG1 {
    bf16_t* ypre; bf16_t* ug; bf16_t* vg; const float* bias;
    __device__ __forceinline__ void operator()(const AccT& acc, const Unit& u, int wr, int wc, int fr, int fq) const {
        if (u.pn < 4) {
#pragma unroll
            for (int n = 0; n < 2; ++n) {
                const int cl = EPI_CL(n); const f32x4 bv = *(const f32x4*)(bias + 128 * u.pn + cl), bg = *(const f32x4*)(bias + 512 + 128 * u.pn + cl);
#pragma unroll
                for (int ai = 0; ai < 2; ++ai)
#pragma unroll
                    for (int m = 0; m < 4; ++m) { const f32x4 val = acc[ai][0][m][n] + bv, gate = acc[ai][1][m][n] + bg; f32x4 y;
#pragma unroll
                        for (int j = 0; j < 4; ++j) y[j] = val[j] * sigmoidf_(gate[j]);
                        *(u32x2*)(ypre + (size_t)EPI_ROWS(ai, m) * 512 + 128 * u.pn + cl) = pack4(y); }
            }
        } else {
            bf16_t* dst = u.pn < 6 ? ug : vg; const int cb = (u.pn & 1) * 256;
#pragma unroll
            for (int bj = 0; bj < 2; ++bj)
#pragma unroll
                for (int n = 0; n < 2; ++n) {
                    const int cl = bj * HALF + EPI_CL(n); const f32x4 bv = *(const f32x4*)(bias + 256 * u.pn + cl);
#pragma unroll
                    for (int ai = 0; ai < 2; ++ai)
#pragma unroll
                        for (int m = 0; m < 4; ++m) { const f32x4 v = acc[ai][bj][m][n] + bv; f32x4 y;
#pragma unroll
                            for (int j = 0; j < 4; ++j) y[j] = gelu_tanh(v[j]);
                            *(u32x2*)(dst + (size_t)EPI_ROWS(ai, m) * 512 + cb + cl) = pack4(y); }
                }
        }
    }
};
struct EpiRes {
    const float* res; float* out; const float* bias;
    __device__ __forceinline__ void operator()(const AccT& acc, const Unit& u, int wr, int wc, int fr, int fq) const {
#pragma unroll
        for (int bj = 0; bj < 2; ++bj)
#pragma unroll
            for (int n = 0; n < 2; ++n) {
                const int col = u.pn * BM + bj * HALF + EPI_CL(n); const f32x4 bv = bias ? *(const f32x4*)(bias + col) : (f32x4){0.f, 0.f, 0.f, 0.f};
#pragma unroll
                for (int ai = 0; ai < 2; ++ai)
#pragma unroll
                    for (int m = 0; m < 4; ++m) { const size_t off = (size_t)EPI_ROWS(ai, m) * DM + col; const f32x4 r4 = *(const f32x4*)(res + off);
                        *(f32x4*)(out + off) = r4 * ALPHA + acc[ai][bj][m][n] + bv; }
            }
    }
};
struct EpiSwiglu {
    bf16_t* hmid;
    __device__ __forceinline__ void operator()(const AccT& acc, const Unit& u, int wr, int wc, int fr, int fq) const {
#pragma unroll
        for (int n = 0; n < 2; ++n) {
            const int col = 128 * u.pn + EPI_CL(n);
#pragma unroll
            for (int ai = 0; ai < 2; ++ai)
#pragma unroll
                for (int m = 0; m < 4; ++m) { const f32x4 g = acc[ai][0][m][n], up = acc[ai][1][m][n]; f32x4 y;
#pragma unroll
                    for (int j = 0; j < 4; ++j) y[j] = g[j] * sigmoidf_(g[j]) * up[j];
                    *(u32x2*)(hmid + (size_t)EPI_ROWS(ai, m) * FH + col) = pack4(y); }
        }
    }
};
template <int MODE> struct EpiBf {
    bf16_t* dst; bf16_t* dst2; size_t gstride; const float* p0; const float* p1;
    __device__ __forceinline__ void operator()(const AccT& acc, const Unit& u, int wr, int wc, int fr, int fq) const {
#pragma unroll
        for (int bj = 0; bj < 2; ++bj)
#pragma unroll
            for (int n = 0; n < 2; ++n) {
                const int col = u.pn * BM + bj * HALF + EPI_CL(n);
                f32x4 pv = (f32x4){0.f, 0.f, 0.f, 0.f};
                if (MODE == 2 || MODE == 4) pv = *(const f32x4*)(p0 + col);
#pragma unroll
                for (int ai = 0; ai < 2; ++ai)
#pragma unroll
                    for (int m = 0; m < 4; ++m) {
                        const size_t row = (size_t)EPI_ROWS(ai, m); f32x4 v = acc[ai][bj][m][n];
                        if (MODE == 0) { *(u32x2*)(dst + (size_t)u.tag * gstride + row * DM + col) = pack4(v); }
                        if (MODE == 3) { *(u32x2*)(dst + row * 512 + col) = pack4(v); }
                        if (MODE == 1) {
                            if (col < 64) {
#pragma unroll
                                for (int j = 0; j < 4; ++j) v[j] = 2.0f * sigmoidf_(2.0f * v[j]) - 1.0f;
                            } else if (col >= 128) {
#pragma unroll
                                for (int j = 0; j < 4; ++j) v[j] = sigmoidf_(v[j]);
                            }
                            *(u32x2*)(dst + row * 256 + col) = pack4(v);
                        }
                        if (MODE == 2) {
                            v += pv;
#pragma unroll
                            for (int j = 0; j < 4; ++j) v[j] = 0.60653066f * sigmoidf_(v[j]);
                            *(u32x2*)(dst + row * DM + col) = pack4(v);
                        }
                        if (MODE == 4) {
                            v += pv;
#pragma unroll
                            for (int j = 0; j < 4; ++j) v[j] = sigmoidf_(v[j]);
                            *(u32x2*)(dst + row * DM + col) = pack4(v);
                        }
                    }
            }
    }
};

template <class Epi, class Sched>
__device__ __forceinline__ void gemm_phase(LAS unsigned char* lds, const bf16_t* Ap, const bf16_t* Btp, const int K, const size_t ldaB, const Sched& S, const Epi& E) {
    int tid = threadIdx.x; asm volatile("" : "+v"(tid));
    const int wid = __builtin_amdgcn_readfirstlane(tid >> 6), lane = tid & 63, wr = wid >> 2, wc = wid & 3, fr = lane & 15, fq = lane >> 4;
    const int nt = K / BK;
    unsigned voffA[2], voffB[2];
#pragma unroll
    for (int i = 0; i < 2; ++i) { int R, C; stage_rc(tid * 16 + i * 8192, R, C); voffA[i] = (unsigned)(R * (int)ldaB + C * 2); voffB[i] = (unsigned)(R * K + C) * 2u; }
    const size_t kstep = (size_t)(BK * 2);
    const size_t hA = (size_t)HALF * ldaB, hB = (size_t)HALF * K * 2;
    const unsigned ldsw = (unsigned)wid * 1024u;
    const int aoff = lds_byte(wr * 64 + fr, fq * 8), boff = lds_byte(wc * 32 + fr, fq * 8);
#define G_SA(b, h) (((b) * 2 + (h)) * HTB)
#define G_SB(b, h) ((4 + (b) * 2 + (h)) * HTB)
#define G_STAGE(bufoff, gbase, voff) do { _Pragma("unroll") for (int _i = 0; _i < 2; ++_i) \
        __builtin_amdgcn_global_load_lds((const unsigned*)((const char*)(gbase) + (voff)[_i]), (LAS unsigned*)(lds + (bufoff) + ldsw + _i * 8192), 16, 0, 0); } while (0)
#define G_LDA(dst, b, h) do { _Pragma("unroll") for (int m = 0; m < 4; ++m) _Pragma("unroll") for (int k = 0; k < 2; ++k) dst[m][k] = *(const LAS bf16x8*)(lds + G_SA(b, h) + aoff + m * 2048 + k * 1024); } while (0)
#define G_LDB(dst, b, h) do { _Pragma("unroll") for (int n = 0; n < 2; ++n) _Pragma("unroll") for (int k = 0; k < 2; ++k) dst[n][k] = *(const LAS bf16x8*)(lds + G_SB(b, h) + boff + n * 2048 + k * 1024); } while (0)
#define G_MMA(ai, bj, At, Bt) do { __builtin_amdgcn_s_setprio(1); _Pragma("unroll") for (int m = 0; m < 4; ++m) _Pragma("unroll") for (int n = 0; n < 2; ++n) _Pragma("unroll") for (int k = 0; k < 2; ++k) \
        acc[ai][bj][m][n] = __builtin_amdgcn_mfma_f32_16x16x32_bf16(Bt[n][k], At[m][k], acc[ai][bj][m][n], 0, 0, 0); __builtin_amdgcn_s_setprio(0); } while (0)
#define G_WAIT_V(n) asm volatile("s_waitcnt vmcnt(" #n ")" ::: "memory")
#define G_WAIT_L(n) asm volatile("s_waitcnt lgkmcnt(" #n ")" ::: "memory")
#define G_BAR __builtin_amdgcn_s_barrier()
#define G_SCHED __builtin_amdgcn_sched_barrier(0)
    Unit cur, nxt; int ui = 0;
    if (!S.next(0, cur)) return;
    f32x4 acc[2][2][4][2];
#pragma unroll
    for (int a = 0; a < 2; ++a)
#pragma unroll
        for (int b = 0; b < 2; ++b)
#pragma unroll
            for (int m = 0; m < 4; ++m)
#pragma unroll
                for (int n = 0; n < 2; ++n) acc[a][b][m][n] = (f32x4){0.f, 0.f, 0.f, 0.f};
    bf16x8 At[4][2], B0[2][2], B1[2][2];
    const char* cA = (const char*)Ap + cur.aoff; const char* cB = (const char*)Btp + cur.boff;
    G_STAGE(G_SB(0, 0), cB, voffB); G_STAGE(G_SA(0, 0), cA, voffA); G_STAGE(G_SB(0, 1), cB + hB, voffB); G_STAGE(G_SA(0, 1), cA + hA, voffA);
    if (wr == 1) G_BAR;
    G_WAIT_V(4); G_BAR;
    G_STAGE(G_SB(1, 0), cB + kstep, voffB); G_STAGE(G_SA(1, 0), cA + kstep, voffA); G_STAGE(G_SB(1, 1), cB + hB + kstep, voffB);
    G_WAIT_V(6); G_BAR;
    for (;;) {
        const bool has_next = S.next(ui + 1, nxt);
        const char* nA = has_next ? (const char*)Ap + nxt.aoff : cA; const char* nB = has_next ? (const char*)Btp + nxt.boff : cB;
        for (int t = 0; t < nt; t += 2) {
            const bool last = (t == nt - 2);
            const char* a1 = cA + (size_t)(t + 1) * kstep;
            const char* a2 = last ? nA : cA + (size_t)(t + 2) * kstep; const char* b2 = last ? nB : cB + (size_t)(t + 2) * kstep;
            const char* a3 = a2 + kstep; const char* b3 = b2 + kstep;
            G_LDB(B0, 0, 0); G_SCHED; G_LDA(At, 0, 0); G_STAGE(G_SA(1, 1), a1 + hA, voffA);
            G_WAIT_L(8); G_BAR; G_WAIT_L(0); G_MMA(0, 0, At, B0); G_BAR; G_SCHED;
            G_LDB(B1, 0, 1); G_STAGE(G_SB(0, 0), b2, voffB);
            G_BAR; G_WAIT_L(0); G_MMA(0, 1, At, B1); G_BAR;
            G_LDA(At, 0, 1); G_STAGE(G_SA(0, 0), a2, voffA);
            G_BAR; G_WAIT_L(0); G_MMA(1, 0, At, B0); G_BAR; G_SCHED;
            G_STAGE(G_SB(0, 1), b2 + hB, voffB);
            G_WAIT_V(6); G_BAR; G_MMA(1, 1, At, B1); G_BAR;
            G_LDB(B0, 1, 0); G_SCHED; G_LDA(At, 1, 0); G_STAGE(G_SA(0, 1), a2 + hA, voffA);
            G_WAIT_L(8); G_BAR; G_WAIT_L(0); G_MMA(0, 0, At, B0); G_BAR; G_SCHED;
            G_LDB(B1, 1, 1); G_STAGE(G_SB(1, 0), b3, voffB);
            G_BAR; G_WAIT_L(0); G_MMA(0, 1, At, B1); G_BAR;
            G_LDA(At, 1, 1); G_STAGE(G_SA(1, 0), a3, voffA);
            G_BAR; G_WAIT_L(0); G_MMA(1, 0, At, B0); G_BAR; G_SCHED;
            G_STAGE(G_SB(1, 1), b3 + hB, voffB);
            G_WAIT_V(6); G_BAR; G_MMA(1, 1, At, B1); G_BAR;
        }
        E(acc, cur, wr, wc, fr, fq);
        if (!has_next) break;
#pragma unroll
        for (int a = 0; a < 2; ++a)
#pragma unroll
            for (int b = 0; b < 2; ++b)
#pragma unroll
                for (int m = 0; m < 4; ++m)
#pragma unroll
                    for (int n = 0; n < 2; ++n) acc[a][b][m][n] = (f32x4){0.f, 0.f, 0.f, 0.f};
        cur = nxt; cA = nA; cB = nB; ++ui;
    }
    G_WAIT_V(0);
    if (wr == 0) G_BAR;
    G_BAR;
#undef G_SA
#undef G_SB
#undef G_STAGE
#undef G_LDA
#undef G_LDB
#undef G_MMA
#undef G_WAIT_V
#undef G_WAIT_L
#undef G_BAR
#undef G_SCHED
}

__device__ __forceinline__ float wsrc(const Args& a, int mat, int n, int k) {
    switch (mat) {
    case 0: { const int g = n >> 10, c = n & 1023; return a.in[14][((size_t)g * 1024 + k) * 1024 + c]; }
    case 1: { const float* W; int col, ld, mi; const int nn = n & 255;
        if (nn < 64) { W = a.in[16]; col = nn; ld = 64; mi = 1; } else if (nn < 128) { W = a.in[19]; col = nn - 64; ld = 64; mi = 4; } else { W = a.in[21]; col = nn - 128; ld = 128; mi = 5; }
        const float mu = a.in[13][mi * 1024 + k]; const float w = W[(size_t)k * ld + col];
        return (n >= 256) ? mu * w : (1.0f - mu) * w; }
    case 2: {
        if (n < 1024) return (k < 64) ? a.in[17][(size_t)k * 1024 + n] : 0.f;
        if (n < 2048) return (k >= 64 && k < 128) ? a.in[20][(size_t)(k - 64) * 1024 + (n - 1024)] : 0.f;
        return (k >= 128) ? a.in[22][(size_t)(k - 128) * 1024 + (n - 2048)] : 0.f; }
    case 3: return a.in[28][(size_t)k * 1024 + n];
    case 4: case 8: { const int l = (mat == 4) ? 1 : 0; const int pn = n >> 8, r = n & 255; const int col = (r < 128) ? 128 * pn + r : FH + 128 * pn + r - 128;
        return a.in[29][(size_t)l * 1024 * 2 * FH + (size_t)k * 2 * FH + col]; }
    case 5: case 9: { const int l = (mat == 5) ? 1 : 0; return a.in[30][(size_t)l * FH * 1024 + (size_t)k * 1024 + n]; }
    case 6: { const int pn = n >> 8, r = n & 255; const int col = (pn < 4) ? ((r < 128) ? 128 * pn + r : 512 + 128 * pn + r - 128) : n; return a.in[1][(size_t)k * 2048 + col]; }
    default: return a.in[11][(size_t)k * 1024 + n];
    }
}
__device__ void prep_phase(const Args& a, LAS unsigned char* lds) {
    LAS float* tile = (LAS float*)lds;
    const int tid0 = tid_opaque(); const int tx = tid0 & 63, ty = tid0 >> 6;
    constexpr int T0 = 768, T1 = T0 + 128, T2 = T1 + 192, T3 = T2 + 256, T4 = T3 + 1408, T5 = T4 + 704, T6 = T5 + 512, T7 = T6 + 256, T8 = T7 + 1408, T9 = T8 + 704;
    for (int t = blockIdx.x; t < T9; t += gridDim.x) {
        int mat, lt, kt; size_t doff; int Kd;
        if (t < T0) { mat = 0; lt = t; kt = 16; doff = O_WRKV; Kd = 1024; }
        else if (t < T1) { mat = 1; lt = t - T0; kt = 16; doff = O_WL1; Kd = 1024; }
        else if (t < T2) { mat = 2; lt = t - T1; kt = 4; doff = O_L2T; Kd = 256; }
        else if (t < T3) { mat = 3; lt = t - T2; kt = 16; doff = O_WOT; Kd = 1024; }
        else if (t < T4) { mat = 4; lt = t - T3; kt = 16; doff = O_F1T1; Kd = 1024; }
        else if (t < T5) { mat = 5; lt = t - T4; kt = 44; doff = O_F2T1; Kd = FH; }
        else if (t < T6) { mat = 6; lt = t - T5; kt = 16; doff = O_W1T; Kd = 1024; }
        else if (t < T7) { mat = 7; lt = t - T6; kt = 16; doff = O_W2T; Kd = 1024; }
        else if (t < T8) { mat = 8; lt = t - T7; kt = 16; doff = O_F1T0; Kd = 1024; }
        else { mat = 9; lt = t - T8; kt = 44; doff = O_F2T0; Kd = FH; }
        const int n0 = (lt / kt) * 64, k0 = (lt % kt) * 64;
#pragma unroll
        for (int i = 0; i < 8; ++i) { const int kk = ty + 8 * i; tile[kk * 65 + tx] = wsrc(a, mat, n0 + tx, k0 + kk); }
        __syncthreads();
        bf16_t* dst = (bf16_t*)(a.ws + doff);
#pragma unroll
        for (int i = 0; i < 8; ++i) { const int nn = ty + 8 * i; dst[(size_t)(n0 + nn) * Kd + k0 + tx] = f2bf(tile[tx * 65 + nn]); }
        __syncthreads();
    }
    const float* x = a.in[0]; bf16_t* xb = (bf16_t*)(a.ws + SLOTP(0));
    for (size_t i = (size_t)blockIdx.x * 512 + tid0; i < (size_t)MT * DM / 4; i += (size_t)gridDim.x * 512) {
        const f32x4 v = *(const f32x4*)(x + 4 * i); *(u32x2*)(xb + 4 * i) = pack4(v);
    }
}

__device__ void conv_tile(const Args& a, LAS unsigned char* lds, int tile) {
    LAS bf16_t* in = (LAS bf16_t*)lds;
    LAS float* outf = (LAS float*)(lds + 63488);
    const bf16_t* ypre = (const bf16_t*)(a.ws + SLOTP(1));
    bf16_t* mixed = (bf16_t*)(a.ws + SLOTP(3));
    const int tid = tid_opaque(), wid = tid >> 6, lane = tid & 63;
    const int m0 = tile * 32, s0 = m0 & (SEQL - 1);
    for (int v = tid; v < 62 * 64; v += 512) {
        const int r = v >> 6, cv = v & 63; u32x4 val = (u32x4){0u, 0u, 0u, 0u};
        if (s0 - 30 + r >= 0) val = *(const u32x4*)(ypre + (size_t)(m0 - 30 + r) * 512 + cv * 8);
        *(LAS u32x4*)(in + r * 512 + cv * 8) = val;
    }
    __syncthreads();
    {
        const int c = tid; const float* cwp = a.in[3]; float cw[31];
#pragma unroll
        for (int w = 0; w < 31; ++w) cw[w] = cwp[w * 512 + c];
        const float cb = a.in[4][c];
        float xin[62];
#pragma unroll
        for (int r = 0; r < 62; ++r) xin[r] = bf2f(in[r * 512 + c]);
#pragma unroll
        for (int tt = 0; tt < 32; ++tt) { float s = cb;
#pragma unroll
            for (int w = 0; w < 31; ++w) s += xin[tt + w] * cw[w];
            outf[tt * 512 + c] = s; }
    }
    __syncthreads();
    {
        const float* g = a.in[5]; const float* b = a.in[6];
        const f32x4 g0 = *(const f32x4*)(g + 4 * lane), g1 = *(const f32x4*)(g + 256 + 4 * lane), b0 = *(const f32x4*)(b + 4 * lane), b1 = *(const f32x4*)(b + 256 + 4 * lane);
        for (int tt = wid; tt < 32; tt += 8) {
            f32x4 v0 = *(const LAS f32x4*)(outf + tt * 512 + 4 * lane), v1 = *(const LAS f32x4*)(outf + tt * 512 + 256 + 4 * lane);
            float s = (v0[0] + v0[1]) + (v0[2] + v0[3]) + (v1[0] + v1[1]) + (v1[2] + v1[3]);
            const float mean = wave_sum(s) * (1.0f / 512.0f);
            v0 -= mean; v1 -= mean;
            float q = v0[0] * v0[0] + v0[1] * v0[1] + v0[2] * v0[2] + v0[3] * v0[3] + v1[0] * v1[0] + v1[1] * v1[1] + v1[2] * v1[2] + v1[3] * v1[3];
            const float rstd = rsqrtf(wave_sum(q) * (1.0f / 512.0f) + 1e-5f);
            v0 = v0 * rstd * g0 + b0; v1 = v1 * rstd * g1 + b1;
#pragma unroll
            for (int j = 0; j < 4; ++j) { v0[j] = v0[j] * sigmoidf_(v0[j]); v1[j] = v1[j] * sigmoidf_(v1[j]); }
            bf16_t* o = mixed + (size_t)(m0 + tt) * DM;
            *(u32x2*)(o + 4 * lane) = pack4(v0); *(u32x2*)(o + 256 + 4 * lane) = pack4(v1);
        }
    }
    __syncthreads();
}
__device__ void sgu_item(const Args& a, LAS unsigned char* lds, int item) {
    LAS bf16_t* Wl = (LAS bf16_t*)lds;
    LAS bf16_t* VT = (LAS bf16_t*)(lds + 34816);
    LAS float* st = (LAS float*)(lds + 69632);
    const bf16_t* ug = (const bf16_t*)(a.ws + SLOTP(1) + 16 * MiB);
    const bf16_t* vg = (const bf16_t*)(a.ws + SLOTP(2));
    bf16_t* mixed = (bf16_t*)(a.ws + SLOTP(3));
    const int tid = tid_opaque(), wid = tid >> 6, lane = tid & 63;
    const int g = item & 3, m0 = (item >> 2) * 128;
    for (int i = 0; i < 16; ++i) {
        const int tok = 16 * wid + i; float f[8]; unpack8(*(const u32x4*)(vg + (size_t)(m0 + tok) * 512 + lane * 8), f);
        float s = 0.f;
#pragma unroll
        for (int e = 0; e < 8; ++e) s += f[e];
        const float mean = wave_sum(s) * (1.0f / 512.0f); float q = 0.f;
#pragma unroll
        for (int e = 0; e < 8; ++e) { const float d = f[e] - mean; q += d * d; }
        const float rstd = rsqrtf(wave_sum(q) * (1.0f / 512.0f) + 1e-5f);
        if (lane == 0) { st[2 * tok] = mean; st[2 * tok + 1] = rstd; }
    }
    __syncthreads();
    {
        const int s = tid & 127, dq = tid >> 7; const float mean = st[2 * s], rstd = st[2 * s + 1];
        const float* sg = a.in[7] + g * 128; const float* sb = a.in[8] + g * 128;
#pragma unroll
        for (int i = 0; i < 4; ++i) {
            const int d0 = (dq * 4 + i) * 8; float f[8]; unpack8(*(const u32x4*)(vg + (size_t)(m0 + s) * 512 + g * 128 + d0), f);
#pragma unroll
            for (int e = 0; e < 8; ++e) VT[(d0 + e) * 136 + s] = f2bf((f[e] - mean) * rstd * sg[d0 + e] + sb[d0 + e]);
        }
        const float* W = a.in[9] + (size_t)g * 128 * 128;
        for (int idx = tid; idx < 128 * 32; idx += 512) {
            const int t = idx >> 5, s4 = (idx & 31) * 4; f32x4 w = *(const f32x4*)(W + t * 128 + s4);
#pragma unroll
            for (int e = 0; e < 4; ++e) if (s4 + e > t) w[e] = 0.f;
            *(LAS u32x2*)(Wl + t * 136 + s4) = pack4(w);
        }
    }
    __syncthreads();
    {
        const int t0 = 16 * wid, row = lane & 15, quad = lane >> 4;
        f32x4 acc[8];
#pragma unroll
        for (int db = 0; db < 8; ++db) acc[db] = (f32x4){0.f, 0.f, 0.f, 0.f};
        for (int s0 = 0; s0 < t0 + 16; s0 += 32) {
            const bf16x8 av = *(const LAS bf16x8*)(Wl + (t0 + row) * 136 + s0 + quad * 8);
#pragma unroll
            for (int db = 0; db < 8; ++db) { const bf16x8 bv = *(const LAS bf16x8*)(VT + (db * 16 + row) * 136 + s0 + quad * 8);
                acc[db] = __builtin_amdgcn_mfma_f32_16x16x32_bf16(av, bv, acc[db], 0, 0, 0); }
        }
        const float* sbias = a.in[10] + g * 128;
#pragma unroll
        for (int db = 0; db < 8; ++db)
#pragma unroll
            for (int j = 0; j < 4; ++j) {
                const int t = t0 + quad * 4 + j, d = db * 16 + row; const float sv = acc[db][j] + sbias[t];
                const float uv = bf2f(ug[(size_t)(m0 + t) * 512 + g * 128 + d]);
                mixed[(size_t)(m0 + t) * DM + 512 + g * 128 + d] = f2bf(uv * sv);
            }
    }
    __syncthreads();
}

struct Row16 { f32x4 v[4]; };
__device__ __forceinline__ void row_load(const float* p, int lane, Row16& r) {
#pragma unroll
    for (int i = 0; i < 4; ++i) r.v[i] = *(const f32x4*)(p + 256 * i + 4 * lane);
}
__device__ __forceinline__ void row_ln(Row16& r, const Row16& g, const Row16& b) {
    float s = 0.f;
#pragma unroll
    for (int i = 0; i < 4; ++i) s += (r.v[i][0] + r.v[i][1]) + (r.v[i][2] + r.v[i][3]);
    const float mean = wave_sum(s) * (1.0f / 1024.0f); float q = 0.f;
#pragma unroll
    for (int i = 0; i < 4; ++i) { r.v[i] -= mean; q += r.v[i][0] * r.v[i][0] + r.v[i][1] * r.v[i][1] + r.v[i][2] * r.v[i][2] + r.v[i][3] * r.v[i][3]; }
    const float rstd = rsqrtf(wave_sum(q) * (1.0f / 1024.0f) + 1e-5f);
#pragma unroll
    for (int i = 0; i < 4; ++i) r.v[i] = r.v[i] * rstd * g.v[i] + b.v[i];
}
__device__ __forceinline__ void row_store_bf(bf16_t* p, int lane, const Row16& r) {
#pragma unroll
    for (int i = 0; i < 4; ++i) *(u32x2*)(p + 256 * i + 4 * lane) = pack4(r.v[i]);
}
__device__ void ln_phase(const float* src, float* dstf, bf16_t* dstb, const float* gp, const float* bp) {
    const int tid = tid_opaque(); const int lane = tid & 63, gw = blockIdx.x * 8 + (tid >> 6), nw = gridDim.x * 8;
    Row16 g, b; row_load(gp, lane, g); row_load(bp, lane, b);
    for (int row = gw; row < MT; row += nw) {
        Row16 r; row_load(src + (size_t)row * DM, lane, r); row_ln(r, g, b);
#pragma unroll
        for (int i = 0; i < 4; ++i) *(f32x4*)(dstf + (size_t)row * DM + 256 * i + 4 * lane) = r.v[i];
        if (dstb) row_store_bf(dstb + (size_t)row * DM, lane, r);
    }
}
__device__ void ln_shift_phase(const Args& a) {
    const float* src = (const float*)(a.ws + SLOTP(4)); float* xf = a.out;
    bf16_t* xr = (bf16_t*)(a.ws + SLOTP(0)); bf16_t* xk = (bf16_t*)(a.ws + SLOTP(1)); bf16_t* xv = (bf16_t*)(a.ws + SLOTP(2)); bf16_t* xg = (bf16_t*)(a.ws + SLOTP(3));
    const int tid = tid_opaque(); const int lane = tid & 63, gw = blockIdx.x * 8 + (tid >> 6), nw = gridDim.x * 8;
    Row16 g, b, mr, mk, mv; row_load(a.in[33], lane, g); row_load(a.in[34], lane, b);
    row_load(a.in[13], lane, mr); row_load(a.in[13] + 2 * 1024, lane, mk); row_load(a.in[13] + 3 * 1024, lane, mv);
    for (int ch = gw; ch < MT / 8; ch += nw) {
        const int r0 = ch * 8; Row16 prev;
        if ((r0 & (SEQL - 1)) == 0) {
#pragma unroll
            for (int i = 0; i < 4; ++i) prev.v[i] = (f32x4){0.f, 0.f, 0.f, 0.f};
        } else { row_load(src + (size_t)(r0 - 1) * DM, lane, prev); row_ln(prev, g, b); }
        for (int r = r0; r < r0 + 8; ++r) {
            Row16 cur; row_load(src + (size_t)r * DM, lane, cur); row_ln(cur, g, b);
#pragma unroll
            for (int i = 0; i < 4; ++i) *(f32x4*)(xf + (size_t)r * DM + 256 * i + 4 * lane) = cur.v[i];
            row_store_bf(xg + (size_t)r * DM, lane, cur);
            Row16 t;
#pragma unroll
            for (int i = 0; i < 4; ++i) t.v[i] = cur.v[i] + (prev.v[i] - cur.v[i]) * mr.v[i];
            row_store_bf(xr + (size_t)r * DM, lane, t);
#pragma unroll
            for (int i = 0; i < 4; ++i) t.v[i] = cur.v[i] + (prev.v[i] - cur.v[i]) * mk.v[i];
            row_store_bf(xk + (size_t)r * DM, lane, t);
#pragma unroll
            for (int i = 0; i < 4; ++i) t.v[i] = cur.v[i] + (prev.v[i] - cur.v[i]) * mv.v[i];
            row_store_bf(xv + (size_t)r * DM, lane, t);
            prev = cur;
        }
    }
}

__device__ void hid_phase(const Args& a) {
    const bf16_t* pq = (const bf16_t*)(a.ws + O_W1T); bf16_t* hid = (bf16_t*)(a.ws + O_HID);
    const int t0 = tid_opaque();
    for (int idx = blockIdx.x * 512 + t0; idx < MT * 64; idx += gridDim.x * 512) {
        const int m = idx >> 6, c4 = (idx & 63) * 4;
        const u32x2 q = *(const u32x2*)(pq + (size_t)m * 512 + c4);
        u32x2 p = (u32x2){0u, 0u}; if (m & (SEQL - 1)) p = *(const u32x2*)(pq + (size_t)(m - 1) * 512 + 256 + c4);
        f32x4 v; v[0] = __uint_as_float(q.x << 16) + __uint_as_float(p.x << 16); v[1] = __uint_as_float(q.x & 0xffff0000u) + __uint_as_float(p.x & 0xffff0000u);
        v[2] = __uint_as_float(q.y << 16) + __uint_as_float(p.y << 16); v[3] = __uint_as_float(q.y & 0xffff0000u) + __uint_as_float(p.y & 0xffff0000u);
        if (c4 < 64) {
#pragma unroll
            for (int j = 0; j < 4; ++j) v[j] = 2.0f * sigmoidf_(2.0f * v[j]) - 1.0f;
        } else if (c4 >= 128) {
#pragma unroll
            for (int j = 0; j < 4; ++j) v[j] = sigmoidf_(v[j]);
        }
        *(u32x2*)(hid + (size_t)m * 256 + c4) = pack4(v);
    }
}

constexpr int TC = 32, SBUF = (5 * TC * 64 + TC * 16) * 4;
__device__ void scan_phase(const Args& a, LAS unsigned char* lds) {
    const bf16_t* rp = (const bf16_t*)(a.ws + SLOTP(4)); const bf16_t* kp = (const bf16_t*)(a.ws + SLOTP(5)); const bf16_t* vp = (const bf16_t*)(a.ws + SLOTP(0));
    const bf16_t* ep = (const bf16_t*)(a.ws + SLOTP(1)); const bf16_t* ap = (const bf16_t*)(a.ws + SLOTP(2));
    bf16_t* yraw = (bf16_t*)(a.ws + SLOTP(3)); float* ct = (float*)(a.ws + O_CT);
    const int tid = tid_opaque(), wid = tid >> 6, lane = tid & 63;
    for (int item = blockIdx.x; item < 256; item += gridDim.x) {
        const int xcd = item & 7, slot = item >> 3, hg = xcd * 8 + (slot >> 2), q = slot & 3, bb = hg >> 4, h = hg & 15;
        const size_t mbase = (size_t)bb * SEQL;
        const int col = h * 64 + lane;
        const float kkc = a.in[23][col], kac = a.in[24][col], rkc = a.in[25][col];
        auto stage = [&](int c, int bufi) {
            LAS float* B = (LAS float*)(lds + bufi * SBUF);
            const int sw = wid - 4;
            float rr[8], kk[8], vv[8], ee[8], aa[8];
#pragma unroll
            for (int i = 0; i < 8; ++i) { const size_t idx = (mbase + c * TC + sw * 8 + i) * DM + col;
                rr[i] = bf2f(rp[idx]); kk[i] = bf2f(kp[idx]); vv[i] = bf2f(vp[idx]); ee[i] = bf2f(ep[idx]); aa[i] = bf2f(ap[idx]); }
#pragma unroll
            for (int i = 0; i < 8; ++i) {
                const int tl = sw * 8 + i;
                const float kkr = kk[i] * kkc; const float ss = wave_sum(kkr * kkr); const float inv = 1.0f / fmaxf(sqrtf(ss), 1e-12f);
                const float nkk = -kkr * inv; const float kpr = kk[i] * (1.0f + (aa[i] - 1.0f) * kac);
                const float cterm = wave_sum(rr[i] * kpr * rkc);
                B[0 * TC * 64 + tl * 64 + lane] = __expf(-ee[i]);
                B[1 * TC * 64 + tl * 64 + lane] = nkk;
                B[2 * TC * 64 + tl * 64 + lane] = -nkk * aa[i];
                B[3 * TC * 64 + tl * 64 + lane] = kpr;
                B[4 * TC * 64 + tl * 64 + lane] = rr[i];
                if ((lane >> 4) == q) B[5 * TC * 64 + tl * 16 + (lane & 15)] = vv[i];
                if (q == 0 && lane == 0) ct[(mbase + c * TC + tl) * 16 + h] = cterm;
            }
        };
        if (wid >= 4) stage(0, 0);
        __syncthreads();
        f32x4 S = (f32x4){0.f, 0.f, 0.f, 0.f};
        const int il = lane >> 4, jl = lane & 15, rowl = 4 * (wid & 3) + il;
        for (int c = 0; c < SEQL / TC; ++c) {
            if (wid >= 4) { if (c + 1 < SEQL / TC) stage(c + 1, (c + 1) & 1); }
            else {
                const LAS float* B = (const LAS float*)(lds + (c & 1) * SBUF);
                bf16_t* yo = yraw + (mbase + c * TC) * DM + h * 64 + 16 * q + rowl;
#pragma unroll 4
                for (int tl = 0; tl < TC; ++tl) {
                    const f32x4 w4 = *(const LAS f32x4*)(B + 0 * TC * 64 + tl * 64 + 4 * jl), n4 = *(const LAS f32x4*)(B + 1 * TC * 64 + tl * 64 + 4 * jl),
                                b4 = *(const LAS f32x4*)(B + 2 * TC * 64 + tl * 64 + 4 * jl), k4 = *(const LAS f32x4*)(B + 3 * TC * 64 + tl * 64 + 4 * jl),
                                r4 = *(const LAS f32x4*)(B + 4 * TC * 64 + tl * 64 + 4 * jl);
                    const float vi = B[5 * TC * 64 + tl * 16 + rowl];
                    float sa = (S[0] * n4[0] + S[1] * n4[1]) + (S[2] * n4[2] + S[3] * n4[3]);
                    sa = red16(sa);
                    S = S * w4 + k4 * vi + b4 * sa;
                    float y = (S[0] * r4[0] + S[1] * r4[1]) + (S[2] * r4[2] + S[3] * r4[3]);
                    y = red16(y);
                    if (jl == 0) yo[(size_t)tl * DM] = f2bf(y);
                }
            }
            __syncthreads();
        }
    }
}
__device__ void post_phase(const Args& a) {
    const bf16_t* yraw = (const bf16_t*)(a.ws + SLOTP(3)); const bf16_t* vp = (const bf16_t*)(a.ws + SLOTP(0)); const bf16_t* gg = (const bf16_t*)(a.ws + SLOTP(4));
    const float* ct = (const float*)(a.ws + O_CT); bf16_t* yb = (bf16_t*)(a.ws + SLOTP(5));
    const int tid = tid_opaque(); const int lane = tid & 63, gw = blockIdx.x * 8 + (tid >> 6), nw = gridDim.x * 8;
    const int c0 = 16 * lane;
    float lg[16], lb[16];
#pragma unroll
    for (int i = 0; i < 16; ++i) { lg[i] = a.in[26][c0 + i]; lb[i] = a.in[27][c0 + i]; }
    for (int row = gw; row < MT; row += nw) {
        const size_t o = (size_t)row * DM + c0; float y[16], v[16], g[16];
        unpack8(*(const u32x4*)(yraw + o), *(float(*)[8])&y[0]); unpack8(*(const u32x4*)(yraw + o + 8), *(float(*)[8])&y[8]);
        unpack8(*(const u32x4*)(vp + o), *(float(*)[8])&v[0]); unpack8(*(const u32x4*)(vp + o + 8), *(float(*)[8])&v[8]);
        unpack8(*(const u32x4*)(gg + o), *(float(*)[8])&g[0]); unpack8(*(const u32x4*)(gg + o + 8), *(float(*)[8])&g[8]);
        const float cv = ct[(size_t)row * 16 + (lane >> 2)];
        float s = 0.f;
#pragma unroll
        for (int i = 0; i < 16; ++i) s += y[i];
        s += dpp_mov<0xB1>(s); s += dpp_mov<0x4E>(s);
        const float mean = s * (1.0f / 64.0f); float qq = 0.f;
#pragma unroll
        for (int i = 0; i < 16; ++i) { y[i] -= mean; qq += y[i] * y[i]; }
        qq += dpp_mov<0xB1>(qq); qq += dpp_mov<0x4E>(qq);
        const float rstd = rsqrtf(qq * (1.0f / 64.0f) + 64e-5f);
        u32x4 w0, w1; float of[16];
#pragma unroll
        for (int i = 0; i < 16; ++i) of[i] = (y[i] * rstd * lg[i] + lb[i] + cv * v[i]) * g[i];
#pragma unroll
        for (int i = 0; i < 4; ++i) { w0[i] = cvt_pk_bf16(of[2 * i], of[2 * i + 1]); w1[i] = cvt_pk_bf16(of[8 + 2 * i], of[8 + 2 * i + 1]); }
        *(u32x4*)(yb + o) = w0; *(u32x4*)(yb + o + 8) = w1;
    }
}

constexpr int NPHASE = 19;
__global__ void __launch_bounds__(512, 2) mk_fwd(Args a) {
    extern __shared__ __attribute__((aligned(16))) unsigned char smem[];
    LAS unsigned char* lds = (LAS unsigned char*)smem;
    cg::grid_group grid = cg::this_grid();
    unsigned char* ws = a.ws;
#define BFP(off) ((bf16_t*)(ws + (off)))
    if (a.ph_lo <= 0 && 0 < a.ph_hi) { if (ONLY < 0 || ONLY == 0) { prep_phase(a, lds); }
        if (0 + 1 < a.ph_hi) grid.sync(); }
    if (a.ph_lo <= 1 && 1 < a.ph_hi) { if (ONLY < 0 || ONLY == 1) { { StaticOrder S{64, 8, 2048, 2048}; EpiG1 E{BFP(SLOTP(1)), BFP(SLOTP(1) + 16 * MiB), BFP(SLOTP(2)), a.in[2]};
            gemm_phase(lds, BFP(SLOTP(0)), BFP(O_W1T), 1024, 2048, S, E); } }
        if (1 + 1 < a.ph_hi) grid.sync(); }
    if (a.ph_lo <= 2 && 2 < a.ph_hi) { if (ONLY < 0 || ONLY == 2) { { for (int t = blockIdx.x; t < 512; t += gridDim.x) conv_tile(a, lds, t);
            for (int t = blockIdx.x; t < 512; t += gridDim.x) sgu_item(a, lds, t); } }
        if (2 + 1 < a.ph_hi) grid.sync(); }
    if (a.ph_lo <= 3 && 3 < a.ph_hi) { if (ONLY < 0 || ONLY == 3) { { StaticOrder S{64, 4, 2048, 2048}; EpiRes E{a.in[0], a.out, a.in[12]}; gemm_phase(lds, BFP(SLOTP(3)), BFP(O_W2T), 1024, 2048, S, E); } }
        if (3 + 1 < a.ph_hi) grid.sync(); }
    if (a.ph_lo <= 4 && 4 < a.ph_hi) { if (ONLY < 0 || ONLY == 4) { ln_phase(a.out, a.out, BFP(SLOTP(0)), a.in[31], a.in[32]); }
        if (4 + 1 < a.ph_hi) grid.sync(); }
    if (a.ph_lo <= 5 && 5 < a.ph_hi) { if (ONLY < 0 || ONLY == 5) { { StaticOrder S{64, 22, 2048, 2048}; EpiSwiglu E{BFP(SLOTP(1))}; gemm_phase(lds, BFP(SLOTP(0)), BFP(O_F1T0), 1024, 2048, S, E); } }
        if (5 + 1 < a.ph_hi) grid.sync(); }
    if (a.ph_lo <= 6 && 6 < a.ph_hi) { if (ONLY < 0 || ONLY == 6) { { StaticOrder S{64, 4, 2 * FH, 2 * FH}; EpiRes E{a.out, (float*)(ws + SLOTP(4)), nullptr}; gemm_phase(lds, BFP(SLOTP(1)), BFP(O_F2T0), FH, 2 * FH, S, E); } }
        if (6 + 1 < a.ph_hi) grid.sync(); }
    if (a.ph_lo <= 7 && 7 < a.ph_hi) { if (ONLY < 0 || ONLY == 7) { ln_shift_phase(a); }
        if (7 + 1 < a.ph_hi) grid.sync(); }
    if (a.ph_lo <= 8 && 8 < a.ph_hi) { if (ONLY < 0 || ONLY == 8) { { StaticOrder S2{64, 2, 2048, 2048}; EpiBf<3> E2{BFP(O_W1T), nullptr, 0, nullptr, nullptr}; gemm_phase(lds, BFP(SLOTP(3)), BFP(O_WL1), 1024, 2048, S2, E2);
            GroupOrder S{2, SLOT}; EpiBf<0> E{BFP(SLOTP(4)), nullptr, SLOT / 2, nullptr, nullptr}; gemm_phase(lds, BFP(SLOTP(0)), BFP(O_WRKV), 1024, 2048, S, E); } }
        if (8 + 1 < a.ph_hi) grid.sync(); }
    if (a.ph_lo <= 9 && 9 < a.ph_hi) { if (ONLY < 0 || ONLY == 9) { { StaticOrder S{64, 4, 2048, 2048}; EpiBf<0> E{BFP(SLOTP(0)), nullptr, 0, nullptr, nullptr}; gemm_phase(lds, BFP(SLOTP(2)), BFP(O_WRKV + 4 * MiB), 1024, 2048, S, E); hid_phase(a); } }
        if (9 + 1 < a.ph_hi) grid.sync(); }
    if (a.ph_lo <= 10 && 10 < a.ph_hi) { if (ONLY < 0 || ONLY == 10) { { StaticOrder S{64, 4, 512, 512}; EpiBf<2> E{BFP(SLOTP(1)), nullptr, 0, a.in[15], nullptr}; gemm_phase(lds, BFP(O_HID), BFP(O_L2T), 256, 512, S, E);
            EpiBf<4> E2{BFP(SLOTP(2)), nullptr, 0, a.in[18], nullptr}; gemm_phase(lds, BFP(O_HID), BFP(O_L2T + 512 * 1024), 256, 512, S, E2); } }
        if (10 + 1 < a.ph_hi) grid.sync(); }
    if (a.ph_lo <= 11 && 11 < a.ph_hi) { if (ONLY < 0 || ONLY == 11) { scan_phase(a, lds); }
        if (11 + 1 < a.ph_hi) grid.sync(); }
    if (a.ph_lo <= 12 && 12 < a.ph_hi) { if (ONLY < 0 || ONLY == 12) { { StaticOrder S{64, 4, 512, 512}; EpiBf<0> E{BFP(SLOTP(4)), nullptr, 0, nullptr, nullptr}; gemm_phase(lds, BFP(O_HID), BFP(O_L2T + 1 * MiB), 256, 512, S, E); } }
        if (12 + 1 < a.ph_hi) grid.sync(); }
    if (a.ph_lo <= 13 && 13 < a.ph_hi) { if (ONLY < 0 || ONLY == 13) { post_phase(a); }
        if (13 + 1 < a.ph_hi) grid.sync(); }
    if (a.ph_lo <= 14 && 14 < a.ph_hi) { if (ONLY < 0 || ONLY == 14) { { StaticOrder S{64, 4, 2048, 2048}; EpiRes E{a.out, a.out, nullptr}; gemm_phase(lds, BFP(SLOTP(5)), BFP(O_WOT), 1024, 2048, S, E); } }
        if (14 + 1 < a.ph_hi) grid.sync(); }
    if (a.ph_lo <= 15 && 15 < a.ph_hi) { if (ONLY < 0 || ONLY == 15) { ln_phase(a.out, a.out, BFP(SLOTP(0)), a.in[31] + 1024, a.in[32] + 1024); }
        if (15 + 1 < a.ph_hi) grid.sync(); }
    if (a.ph_lo <= 16 && 16 < a.ph_hi) { if (ONLY < 0 || ONLY == 16) { { StaticOrder S{64, 22, 2048, 2048}; EpiSwiglu E{BFP(SLOTP(1))}; gemm_phase(lds, BFP(SLOTP(0)), BFP(O_F1T1), 1024, 2048, S, E); } }
        if (16 + 1 < a.ph_hi) grid.sync(); }
    if (a.ph_lo <= 17 && 17 < a.ph_hi) { if (ONLY < 0 || ONLY == 17) { { StaticOrder S{64, 4, 2 * FH, 2 * FH}; EpiRes E{a.out, a.out, nullptr}; gemm_phase(lds, BFP(SLOTP(1)), BFP(O_F2T1), FH, 2 * FH, S, E); } }
        if (17 + 1 < a.ph_hi) grid.sync(); }
    if (a.ph_lo <= 18 && 18 < a.ph_hi) { if (ONLY < 0 || ONLY == 18) { ln_phase(a.out, a.out, nullptr, a.in[33] + 1024, a.in[34] + 1024); }
        if (18 + 1 < a.ph_hi) grid.sync(); }
    if (a.ph_lo <= 19 && 19 < a.ph_hi) { const bf16_t* src = BFP(DUMP_OFF); const int t0 = tid_opaque();
        for (size_t i = (size_t)blockIdx.x * 512 + t0; i < (size_t)MT * DM; i += (size_t)gridDim.x * 512) a.out[i] = bf2f(src[i]); }
#undef BFP
}

extern "C" void kernel_launch(void* const* d_in, const int* in_sizes, int n_in, void* d_out, int out_size, void* d_ws, size_t ws_size, hipStream_t stream) {
    static int grid_blocks = 0;
    if (grid_blocks == 0) {
        if (n_in != 35 || out_size != MT * DM || ws_size < WS_END) { fprintf(stderr, "kernel_launch: unexpected shapes (n_in %d out %d ws %zu need %zu)\n", n_in, out_size, ws_size, (size_t)WS_END); grid_blocks = -1; return; }
        int dev = 0, cus = 0, per_cu = 0;
        hipGetDevice(&dev); hipDeviceGetAttribute(&cus, hipDeviceAttributeMultiprocessorCount, dev);
        hipFuncSetAttribute((const void*)mk_fwd, hipFuncAttributeMaxDynamicSharedMemorySize, STAGE_BYTES);
        hipOccupancyMaxActiveBlocksPerMultiprocessor(&per_cu, (const void*)mk_fwd, 512, STAGE_BYTES);
        if (per_cu < 1) per_cu = 1;
        grid_blocks = cus * per_cu;
        if (grid_blocks > 256) grid_blocks = 256;
    }
    if (grid_blocks < 0) return;
    Args a{};
    for (int i = 0; i < 35; ++i) a.in[i] = (const float*)d_in[i];
    a.out = (float*)d_out; a.ws = (unsigned char*)d_ws;
#if PER_PHASE_LAUNCH
    for (int ph = 0; ph < NPHASE && ph <= STOP_AFTER; ++ph) {
        a.ph_lo = ph; a.ph_hi = ph + 1; void* args[] = {&a};
        hipError_t e = hipLaunchCooperativeKernel((const void*)mk_fwd, dim3(grid_blocks), dim3(512), args, STAGE_BYTES, stream);
        if (e != hipSuccess) { fprintf(stderr, "cooperative launch failed: %s\n", hipGetErrorString(e)); return; }
    }
    if (STOP_AFTER < NPHASE - 1) { a.ph_lo = 19; a.ph_hi = 20; void* args[] = {&a};
        (void)hipLaunchCooperativeKernel((const void*)mk_fwd, dim3(grid_blocks), dim3(512), args, STAGE_BYTES, stream); }
#else
    a.ph_lo = 0; a.ph_hi = NPHASE; void* args[] = {&a};
    hipError_t e = hipLaunchCooperativeKernel((const void*)mk_fwd, dim3(grid_blocks), dim3(512), args, STAGE_BYTES, stream);
    if (e != hipSuccess) fprintf(stderr, "cooperative launch failed: %s (grid %d)\n", hipGetErrorString(e), grid_blocks);
#endif
}
```

```cpp
#include <hip/hip_runtime.h>
#include <hip/hip_cooperative_groups.h>
#include <cstdio>
namespace cg = cooperative_groups;

#ifndef PER_PHASE_LAUNCH
#define PER_PHASE_LAUNCH 0
#endif

#ifndef STOP_AFTER
#define STOP_AFTER 99
#endif
#ifndef DUMP_OFF
#define DUMP_OFF SLOTP(2)
#endif
#ifndef DUP
#define DUP -1
#endif
#ifndef ONLY
#define ONLY -1
#endif
#define LAS __attribute__((address_space(3)))
typedef unsigned short bf16_t;
typedef short bf16x8 __attribute__((ext_vector_type(8)));
typedef float f32x4 __attribute__((ext_vector_type(4)));
typedef unsigned u32x4 __attribute__((ext_vector_type(4)));
typedef unsigned u32x2 __attribute__((ext_vector_type(2)));

constexpr int MT = 16384, DM = 1024, SEQL = 4096, FH = 2816;
constexpr float ALPHA = 1.41421356237f;
constexpr size_t MiB = 1ull << 20;
constexpr size_t O_WRKV = 0;
constexpr size_t O_WL1 = 6 * MiB;
constexpr size_t O_L2T = 7 * MiB;
constexpr size_t O_WOT = 8 * MiB + 512 * 1024;
constexpr size_t O_F1T1 = 10 * MiB + 512 * 1024;
constexpr size_t O_F2T1 = 21 * MiB + 512 * 1024;
constexpr size_t O_W1T = 27 * MiB;
constexpr size_t O_W2T = 31 * MiB;
constexpr size_t O_F1T0 = 33 * MiB;
constexpr size_t O_F2T0 = 44 * MiB;
constexpr size_t O_CT = 50 * MiB;
constexpr size_t O_SLOT = 52 * MiB;
constexpr size_t SLOT = 32 * MiB + 64 * 1024;
constexpr size_t O_HID = O_SLOT + 6 * SLOT;
constexpr size_t WS_END = O_HID + 8 * MiB;
#define SLOTP(i) (O_SLOT + (size_t)(i) * SLOT)

struct Args { const float* in[35]; float* out; unsigned char* ws; int ph_lo, ph_hi; };

__device__ __forceinline__ float bf2f(bf16_t v) { return __uint_as_float((unsigned)v << 16); }
typedef float f32x2 __attribute__((ext_vector_type(2)));
typedef __bf16 bf16x2n __attribute__((ext_vector_type(2)));
__device__ __forceinline__ unsigned cvt_pk_bf16(float lo, float hi) { const f32x2 v = {lo, hi}; return __builtin_bit_cast(unsigned, __builtin_convertvector(v, bf16x2n)); }
__device__ __forceinline__ bf16_t f2bf(float f) { return (bf16_t)(cvt_pk_bf16(f, 0.f) & 0xffffu); }
__device__ __forceinline__ float sigmoidf_(float z) { return __builtin_amdgcn_rcpf(1.0f + __expf(-z)); }
__device__ __forceinline__ float gelu_tanh(float x) { return x * sigmoidf_(1.5957691216f * (x + 0.044715f * x * x * x)); }
__device__ __forceinline__ int tid_opaque() { int t = threadIdx.x; asm volatile("" : "+v"(t)); return t; }
template <int CTRL> __device__ __forceinline__ float dpp_mov(float v) { return __int_as_float(__builtin_amdgcn_update_dpp(0, __float_as_int(v), CTRL, 0xF, 0xF, true)); }
__device__ __forceinline__ float red16(float v) { v += dpp_mov<0xB1>(v); v += dpp_mov<0x4E>(v); v += dpp_mov<0x141>(v); v += dpp_mov<0x140>(v); return v; }
__device__ __forceinline__ float wave_sum(float v) {
    v = red16(v);
    return ((__int_as_float(__builtin_amdgcn_readlane(__float_as_int(v), 0)) + __int_as_float(__builtin_amdgcn_readlane(__float_as_int(v), 16))) + (__int_as_float(__builtin_amdgcn_readlane(__float_as_int(v), 32)) + __int_as_float(__builtin_amdgcn_readlane(__float_as_int(v), 48))));
}
__device__ __forceinline__ float wave_sum_old(float v) {
#pragma unroll
    for (int o = 32; o; o >>= 1) v += __shfl_xor(v, o);
    return v;
}
__device__ __forceinline__ u32x2 pack4(f32x4 v) { u32x2 w; w.x = cvt_pk_bf16(v[0], v[1]); w.y = cvt_pk_bf16(v[2], v[3]); return w; }
__device__ __forceinline__ void unpack8(u32x4 r, float (&f)[8]) {
#pragma unroll
    for (int i = 0; i < 4; ++i) { f[2 * i] = __uint_as_float(r[i] << 16); f[2 * i + 1] = __uint_as_float(r[i] & 0xffff0000u); }
}

constexpr int BM = 256, BK = 64, HALF = 128, HTB = HALF * BK * 2, STAGE_BYTES = 8 * HTB, NXCD = 8, WGM = 8;
__device__ __forceinline__ int lds_byte(int r, int c) { const int st = (r >> 4) * 2 + (c >> 5), rr = r & 15, cc = c & 31, ob = rr * 64 + cc * 2; return st * 1024 + (ob ^ (((ob >> 9) & 1) << 5)); }
__device__ __forceinline__ void stage_rc(int b, int& R, int& C) { const int st = b / 1024, sb = b % 1024, swz = sb ^ (((sb >> 9) & 1) << 5); R = (st >> 1) * 16 + swz / 64; C = (st & 1) * 32 + (swz % 64) / 2; }

struct Unit { int pm, pn, tag; size_t aoff, boff; };
__device__ __forceinline__ void remap_tile(int wgid, int nM, int nN, int& pm, int& pn) {
    const int nwg = nM * nN;
    { const int q = nwg / NXCD, r = nwg % NXCD, xcd = wgid % NXCD, off = wgid / NXCD; wgid = (xcd < r ? xcd * (q + 1) : r * (q + 1) + (xcd - r) * q) + off; }
    const int nig = WGM * nN, gid = wgid / nig, fm = gid * WGM, gsz = (nM - fm) < WGM ? (nM - fm) : WGM;
    pm = fm + ((wgid % nig) % gsz); pn = (wgid % nig) / gsz;
}
struct StaticOrder {
    int nM, nN; size_t ldaB, ldbB;
    __device__ __forceinline__ bool next(int i, Unit& u) const {
        const long L = (long)i * gridDim.x + blockIdx.x; if (L >= (long)nM * nN) return false;
        remap_tile((int)L, nM, nN, u.pm, u.pn); u.tag = 0; u.aoff = (size_t)u.pm * BM * ldaB; u.boff = (size_t)u.pn * BM * ldbB; return true;
    }
};
struct GroupOrder {
    int ngr; size_t astride;
    __device__ __forceinline__ bool next(int i, Unit& u) const {
        const long L = (long)i * gridDim.x + blockIdx.x; if (L >= (long)ngr * 256) return false;
        const int g = (int)(L >> 8); remap_tile((int)(L & 255), 64, 4, u.pm, u.pn); u.tag = g;
        u.aoff = (size_t)g * astride + (size_t)u.pm * BM * 2048; u.boff = (size_t)(g * 4 + u.pn) * BM * 2048; return true;
    }
};
struct LoraOrder {
    __device__ __forceinline__ bool next(int i, Unit& u) const {
        const long L = (long)i * gridDim.x + blockIdx.x; if (L >= 64) return false;
        u.pm = (int)L; u.pn = 0; u.tag = 0; u.aoff = (size_t)(256 * u.pm + (u.pm >> 4)) * 2048; u.boff = 0; return true;
    }
};

#define EPI_ROWS(ai, m) (u.pm * BM + (ai) * HALF + wr * 64 + (m) * 16 + fr)
#define EPI_CL(n) (wc * 32 + (n) * 16 + 4 * fq)
typedef f32x4 AccT[2][2][4][2];

struct EpiG1 {
    bf16_t* ypre; bf16_t* ug; bf16_t* vg; const float* bias;
    __device__ __forceinline__ void operator()(const AccT& acc, const Unit& u, int wr, int wc, int fr, int fq) const {
        if (u.pn < 4) {
#pragma unroll
            for (int n = 0; n < 2; ++n) {
                const int cl = EPI_CL(n); const f32x4 bv = *(const f32x4*)(bias + 128 * u.pn + cl), bg = *(const f32x4*)(bias + 512 + 128 * u.pn + cl);
#pragma unroll
                for (int ai = 0; ai < 2; ++ai)
#pragma unroll
                    for (int m = 0; m < 4; ++m) { const f32x4 val = acc[ai][0][m][n] + bv, gate = acc[ai][1][m][n] + bg; f32x4 y;
#pragma unroll
                        for (int j = 0; j < 4; ++j) y[j] = val[j] * sigmoidf_(gate[j]);
                        *(u32x2*)(ypre + (size_t)EPI_ROWS(ai, m) * 512 + 128 * u.pn + cl) = pack4(y); }
            }
        } else {
            bf16_t* dst = u.pn < 6 ? ug : vg; const int cb = (u.pn & 1) * 256;
#pragma unroll
            for (int bj = 0; bj < 2; ++bj)
#pragma unroll
                for (int n = 0; n < 2; ++n) {
                    const int cl = bj * HALF + EPI_CL(n); const f32x4 bv = *(const f32x4*)(bias + 256 * u.pn + cl);
#pragma unroll
                    for (int ai = 0; ai < 2; ++ai)
#pragma unroll
                        for (int m = 0; m < 4; ++m) { const f32x4 v = acc[ai][bj][m][n] + bv; f32x4 y;
#pragma unroll
                            for (int j = 0; j < 4; ++j) y[j] = gelu_tanh(v[j]);
                            *(u32x2*)(dst + (size_t)EPI_ROWS(ai, m) * 512 + cb + cl) = pack4(y); }
                }
        }
    }
};
struct EpiRes {
    const float* res; float* out; const float* bias;
    __device__ __forceinline__ void operator()(const AccT& acc, const Unit& u, int wr, int wc, int fr, int fq) const {
#pragma unroll
        for (int bj = 0; bj < 2; ++bj)
#pragma unroll
            for (int n = 0; n < 2; ++n) {
                const int col = u.pn * BM + bj * HALF + EPI_CL(n); const f32x4 bv = bias ? *(const f32x4*)(bias + col) : (f32x4){0.f, 0.f, 0.f, 0.f};
#pragma unroll
                for (int ai = 0; ai < 2; ++ai)
#pragma unroll
                    for (int m = 0; m < 4; ++m) { const size_t off = (size_t)EPI_ROWS(ai, m) * DM + col; const f32x4 r4 = *(const f32x4*)(res + off);
                        *(f32x4*)(out + off) = r4 * ALPHA + acc[ai][bj][m][n] + bv; }
            }
    }
};
struct EpiSwiglu {
    bf16_t* hmid;
    __device__ __forceinline__ void operator()(const AccT& acc, const Unit& u, int wr, int wc, int fr, int fq) const {
#pragma unroll
        for (int n = 0; n < 2; ++n) {
            const int col = 128 * u.pn + EPI_CL(n);
#pragma unroll
            for (int ai = 0; ai < 2; ++ai)
#pragma unroll
                for (int m = 0; m < 4; ++m) { const f32x4 g = acc[ai][0][m][n], up = acc[ai][1][m][n]; f32x4 y;
#pragma unroll
                    for (int j = 0; j < 4; ++j) y[j] = g[j] * sigmoidf_(g[j]) * up[j];
                    *(u32x2*)(hmid + (size_t)EPI_ROWS(ai, m) * FH + col) = pack4(y); }
        }
    }
};
template <int MODE> struct EpiBf {
    bf16_t* dst; bf16_t* dst2; size_t gstride; const float* p0; const float* p1;
    __device__ __forceinline__ void operator()(const AccT& acc, const Unit& u, int wr, int wc, int fr, int fq) const {
#pragma unroll
        for (int bj = 0; bj < 2; ++bj)
#pragma unroll
            for (int n = 0; n < 2; ++n) {
                const int col = u.pn * BM + bj * HALF + EPI_CL(n);
                f32x4 pv = (f32x4){0.f, 0.f, 0.f, 0.f};
                if (MODE == 2 || MODE == 4) pv = *(const f32x4*)(p0 + col);
#pragma unroll
                for (int ai = 0; ai < 2; ++ai)
#pragma unroll
                    for (int m = 0; m < 4; ++m) {
                        const size_t row = (size_t)EPI_ROWS(ai, m); f32x4 v = acc[ai][bj][m][n];
                        if (MODE == 0) { *(u32x2*)(dst + (size_t)u.tag * gstride + row * DM + col) = pack4(v); }
                        if (MODE == 3) { *(u32x2*)(dst + row * 512 + col) = pack4(v); }
                        if (MODE == 1) {
                            if (col < 64) {
#pragma unroll
                                for (int j = 0; j < 4; ++j) v[j] = 2.0f * sigmoidf_(2.0f * v[j]) - 1.0f;
                            } else if (col >= 128) {
#pragma unroll
                                for (int j = 0; j < 4; ++j) v[j] = sigmoidf_(v[j]);
                            }
                            *(u32x2*)(dst + row * 256 + col) = pack4(v);
                        }
                        if (MODE == 2) {
                            v += pv;
#pragma unroll
                            for (int j = 0; j < 4; ++j) v[j] = 0.60653066f * sigmoidf_(v[j]);
                            *(u32x2*)(dst + row * DM + col) = pack4(v);
                        }
                        if (MODE == 4) {
                            v += pv;
#pragma unroll
                            for (int j = 0; j < 4; ++j) v[j] = sigmoidf_(v[j]);
                            *(u32x2*)(dst + row * DM + col) = pack4(v);
                        }
                    }
            }
    }
};

template <class Epi, class Sched>
__device__ __forceinline__ void gemm_phase(LAS unsigned char* lds, const bf16_t* Ap, const bf16_t* Btp, const int K, const size_t ldaB, const Sched& S, const Epi& E) {
    int tid = threadIdx.x; asm volatile("" : "+v"(tid));
    const int wid = __builtin_amdgcn_readfirstlane(tid >> 6), lane = tid & 63, wr = wid >> 2, wc = wid & 3, fr = lane & 15, fq = lane >> 4;
    const int nt = K / BK;
    unsigned voffA[2], voffB[2];
#pragma unroll
    for (int i = 0; i < 2; ++i) { int R, C; stage_rc(tid * 16 + i * 8192, R, C); voffA[i] = (unsigned)(R * (int)ldaB + C * 2); voffB[i] = (unsigned)(R * K + C) * 2u; }
    const size_t kstep = (size_t)(BK * 2);
    const size_t hA = (size_t)HALF * ldaB, hB = (size_t)HALF * K * 2;
    const unsigned ldsw = (unsigned)wid * 1024u;
    const int aoff = lds_byte(wr * 64 + fr, fq * 8), boff = lds_byte(wc * 32 + fr, fq * 8);
#define G_SA(b, h) (((b) * 2 + (h)) * HTB)
#define G_SB(b, h) ((4 + (b) * 2 + (h)) * HTB)
#define G_STAGE(bufoff, gbase, voff) do { _Pragma("unroll") for (int _i = 0; _i < 2; ++_i) \
        __builtin_amdgcn_global_load_lds((const unsigned*)((const char*)(gbase) + (voff)[_i]), (LAS unsigned*)(lds + (bufoff) + ldsw + _i * 8192), 16, 0, 0); } while (0)
#define G_LDA(dst, b, h) do { _Pragma("unroll") for (int m = 0; m < 4; ++m) _Pragma("unroll") for (int k = 0; k < 2; ++k) dst[m][k] = *(const LAS bf16x8*)(lds + G_SA(b, h) + aoff + m * 2048 + k * 1024); } while (0)
#define G_LDB(dst, b, h) do { _Pragma("unroll") for (int n = 0; n < 2; ++n) _Pragma("unroll") for (int k = 0; k < 2; ++k) dst[n][k] = *(const LAS bf16x8*)(lds + G_SB(b, h) + boff + n * 2048 + k * 1024); } while (0)
#define G_MMA(ai, bj, At, Bt) do { __builtin_amdgcn_s_setprio(1); _Pragma("unroll") for (int m = 0; m < 4; ++m) _Pragma("unroll") for (int n = 0; n < 2; ++n) _Pragma("unroll") for (int k = 0; k < 2; ++k) \
        acc[ai][bj][m][n] = __builtin_amdgcn_mfma_f32_16x16x32_bf16(Bt[n][k], At[m][k], acc[ai][bj][m][n], 0, 0, 0); __builtin_amdgcn_s_setprio(0); } while (0)
#define G_WAIT_V(n) asm volatile("s_waitcnt vmcnt(" #n ")" ::: "memory")
#define G_WAIT_L(n) asm volatile("s_waitcnt lgkmcnt(" #n ")" ::: "memory")
#define G_BAR __builtin_amdgcn_s_barrier()
#define G_SCHED __builtin_amdgcn_sched_barrier(0)
    Unit cur, nxt; int ui = 0;
    if (!S.next(0, cur)) return;
    f32x4 acc[2][2][4][2];
#pragma unroll
    for (int a = 0; a < 2; ++a)
#pragma unroll
        for (int b = 0; b < 2; ++b)
#pragma unroll
            for (int m = 0; m < 4; ++m)
#pragma unroll
                for (int n = 0; n < 2; ++n) acc[a][b][m][n] = (f32x4){0.f, 0.f, 0.f, 0.f};
    bf16x8 At[4][2], B0[2][2], B1[2][2];
    const char* cA = (const char*)Ap + cur.aoff; const char* cB = (const char*)Btp + cur.boff;
    G_STAGE(G_SB(0, 0), cB, voffB); G_STAGE(G_SA(0, 0), cA, voffA); G_STAGE(G_SB(0, 1), cB + hB, voffB); G_STAGE(G_SA(0, 1), cA + hA, voffA);
    if (wr == 1) G_BAR;
    G_WAIT_V(4); G_BAR;
    G_STAGE(G_SB(1, 0), cB + kstep, voffB); G_STAGE(G_SA(1, 0), cA + kstep, voffA); G_STAGE(G_SB(1, 1), cB + hB + kstep, voffB);
    G_WAIT_V(6); G_BAR;
    for (;;) {
        const bool has_next = S.next(ui + 1, nxt);
        const char* nA = has_next ? (const char*)Ap + nxt.aoff : cA; const char* nB = has_next ? (const char*)Btp + nxt.boff : cB;
        for (int t = 0; t < nt; t += 2) {
            const bool last = (t == nt - 2);
            const char* a1 = cA + (size_t)(t + 1) * kstep;
            const char* a2 = last ? nA : cA + (size_t)(t + 2) * kstep; const char* b2 = last ? nB : cB + (size_t)(t + 2) * kstep;
            const char* a3 = a2 + kstep; const char* b3 = b2 + kstep;
            G_LDB(B0, 0, 0); G_SCHED; G_LDA(At, 0, 0); G_STAGE(G_SA(1, 1), a1 + hA, voffA);
            G_WAIT_L(8); G_BAR; G_WAIT_L(0); G_MMA(0, 0, At, B0); G_BAR; G_SCHED;
            G_LDB(B1, 0, 1); G_STAGE(G_SB(0, 0), b2, voffB);
            G_BAR; G_WAIT_L(0); G_MMA(0, 1, At, B1); G_BAR;
            G_LDA(At, 0, 1); G_STAGE(G_SA(0, 0), a2, voffA);
            G_BAR; G_WAIT_L(0); G_MMA(1, 0, At, B0); G_BAR; G_SCHED;
            G_STAGE(G_SB(0, 1), b2 + hB, voffB);
            G_WAIT_V(6); G_BAR; G_MMA(1, 1, At, B1); G_BAR;
            G_LDB(B0, 1, 0); G_SCHED; G_LDA(At, 1, 0); G_STAGE(G_SA(0, 1), a2 + hA, voffA);
            G_WAIT_L(8); G_BAR; G_WAIT_L(0); G_MMA(0, 0, At, B0); G_BAR; G_SCHED;
            G_LDB(B1, 1, 1); G_STAGE(G_SB(1, 0), b3, voffB);
            G_BAR; G_WAIT_L(0); G_MMA(0, 1, At, B1); G_BAR;
            G_LDA(At, 1, 1); G_STAGE(G_SA(1, 0), a3, voffA);
            G_BAR; G_WAIT_L(0); G_MMA(1, 0, At, B0); G_BAR; G_SCHED;
            G_STAGE(G_SB(1, 1), b3 + hB, voffB);
            G_WAIT_V(6); G_BAR; G_MMA(1, 1, At, B1); G_BAR;
        }
        E(acc, cur, wr, wc, fr, fq);
        if (!has_next) break;
#pragma unroll
        for (int a = 0; a < 2; ++a)
#pragma unroll
            for (int b = 0; b < 2; ++b)
#pragma unroll
                for (int m = 0; m < 4; ++m)
#pragma unroll
                    for (int n = 0; n < 2; ++n) acc[a][b][m][n] = (f32x4){0.f, 0.f, 0.f, 0.f};
        cur = nxt; cA = nA; cB = nB; ++ui;
    }
    G_WAIT_V(0);
    if (wr == 0) G_BAR;
    G_BAR;
#undef G_SA
#undef G_SB
#undef G_STAGE
#undef G_LDA
#undef G_LDB
#undef G_MMA
#undef G_WAIT_V
#undef G_WAIT_L
#undef G_BAR
#undef G_SCHED
}

__device__ void prep_phase(const Args& a, LAS unsigned char* lds) {
    LAS float* tile = (LAS float*)lds;
    const int tid0 = tid_opaque(); const int tx = tid0 & 63, ty = tid0 >> 6;
    constexpr int T0 = 768, T1 = T0 + 128, T2 = T1 + 192, T3 = T2 + 256, T4 = T3 + 1408, T5 = T4 + 704, T6 = T5 + 512, T7 = T6 + 256, T8 = T7 + 1408, T9 = T8 + 704;
    for (int t = blockIdx.x; t < T9; t += gridDim.x) {
        int mat, lt, kt; size_t doff; int Kd;
        if (t < T0) { mat = 0; lt = t; kt = 16; doff = O_WRKV; Kd = 1024; }
        else if (t < T1) { mat = 1; lt = t - T0; kt = 16; doff = O_WL1; Kd = 1024; }
        else if (t < T2) { mat = 2; lt = t - T1; kt = 4; doff = O_L2T; Kd = 256; }
        else if (t < T3) { mat = 3; lt = t - T2; kt = 16; doff = O_WOT; Kd = 1024; }
        else if (t < T4) { mat = 4; lt = t - T3; kt = 16; doff = O_F1T1; Kd = 1024; }
        else if (t < T5) { mat = 5; lt = t - T4; kt = 44; doff = O_F2T1; Kd = FH; }
        else if (t < T6) { mat = 6; lt = t - T5; kt = 16; doff = O_W1T; Kd = 1024; }
        else if (t < T7) { mat = 7; lt = t - T6; kt = 16; doff = O_W2T; Kd = 1024; }
        else if (t < T8) { mat = 8; lt = t - T7; kt = 16; doff = O_F1T0; Kd = 1024; }
        else { mat = 9; lt = t - T8; kt = 44; doff = O_F2T0; Kd = FH; }
        const int n0 = (lt / kt) * 64, k0 = (lt % kt) * 64;
        const float* base = nullptr; int ld = 1024, mode = 0; const float* mup = a.in[13];
        if (mat == 0) { base = a.in[14] + ((size_t)(n0 >> 10) * 1024 + k0) * 1024 + (n0 & 1023); }
        else if (mat == 1) { const int nn = n0 & 255; int mi;
            if (nn < 64) { base = a.in[16] + (size_t)k0 * 64; ld = 64; mi = 1; } else if (nn < 128) { base = a.in[19] + (size_t)k0 * 64; ld = 64; mi = 4; } else { base = a.in[21] + (size_t)k0 * 128 + (nn - 128); ld = 128; mi = 5; }
            mode = (n0 >= 256) ? 1 : 2; mup = a.in[13] + mi * 1024 + k0; }
        else if (mat == 2) {
            if (n0 < 1024) { if (k0 == 0) base = a.in[17] + n0; else mode = 3; }
            else if (n0 < 2048) { if (k0 == 64) base = a.in[20] + (n0 - 1024); else mode = 3; }
            else { if (k0 >= 128) base = a.in[22] + (size_t)(k0 - 128) * 1024 + (n0 - 2048); else mode = 3; } }
        else if (mat == 3) { base = a.in[28] + (size_t)k0 * 1024 + n0; }
        else if (mat == 4 || mat == 8) { const int pn = n0 >> 8, r = n0 & 255; const int col0 = (r < 128) ? 128 * pn + r : FH + 128 * pn + r - 128; ld = 2 * FH;
            base = a.in[29] + (size_t)(mat == 4 ? 1 : 0) * 1024 * 2 * FH + (size_t)k0 * 2 * FH + col0; }
        else if (mat == 5 || mat == 9) { base = a.in[30] + (size_t)(mat == 5 ? 1 : 0) * FH * 1024 + (size_t)k0 * 1024 + n0; }
        else if (mat == 6) { const int pn = n0 >> 8, r = n0 & 255; const int col0 = (pn < 4) ? ((r < 128) ? 128 * pn + r : 512 + 128 * pn + r - 128) : n0; ld = 2048; base = a.in[1] + (size_t)k0 * 2048 + col0; }
        else { base = a.in[11] + (size_t)k0 * 1024 + n0; }
        if (mode == 3) {
#pragma unroll
            for (int i = 0; i < 8; ++i) tile[(ty + 8 * i) * 65 + tx] = 0.f;
        } else {
            float v[8];
#pragma unroll
            for (int i = 0; i < 8; ++i) v[i] = base[(size_t)(ty + 8 * i) * ld + tx];
            if (mode == 1) {
#pragma unroll
                for (int i = 0; i < 8; ++i) v[i] *= mup[ty + 8 * i];
            } else if (mode == 2) {
#pragma unroll
                for (int i = 0; i < 8; ++i) v[i] *= (1.0f - mup[ty + 8 * i]);
            }
#pragma unroll
            for (int i = 0; i < 8; ++i) tile[(ty + 8 * i) * 65 + tx] = v[i];
        }
        __syncthreads();
        bf16_t* dst = (bf16_t*)(a.ws + doff);
        const int kq = tid0 & 15, nr = tid0 >> 4;
#pragma unroll
        for (int i = 0; i < 2; ++i) { const int n = nr + 32 * i;
            f32x4 w; w[0] = tile[(4 * kq + 0) * 65 + n]; w[1] = tile[(4 * kq + 1) * 65 + n]; w[2] = tile[(4 * kq + 2) * 65 + n]; w[3] = tile[(4 * kq + 3) * 65 + n];
            *(u32x2*)(dst + (size_t)(n0 + n) * Kd + k0 + 4 * kq) = pack4(w); }
        __syncthreads();
    }
    const float* x = a.in[0]; bf16_t* xb = (bf16_t*)(a.ws + SLOTP(0));
    for (size_t i = (size_t)blockIdx.x * 512 + tid0; i < (size_t)MT * DM / 4; i += (size_t)gridDim.x * 512) {
        const f32x4 v = *(const f32x4*)(x + 4 * i); *(u32x2*)(xb + 4 * i) = pack4(v);
    }
}

__device__ void conv_tile(const Args& a, LAS unsigned char* lds, int tile) {
    LAS bf16_t* in = (LAS bf16_t*)lds;
    LAS float* outf = (LAS float*)(lds + 63488);
    const bf16_t* ypre = (const bf16_t*)(a.ws + SLOTP(1));
    bf16_t* mixed = (bf16_t*)(a.ws + SLOTP(3));
    const int tid = tid_opaque(), wid = tid >> 6, lane = tid & 63;
    const int m0 = tile * 32, s0 = m0 & (SEQL - 1);
    for (int v = tid; v < 62 * 64; v += 512) {
        const int r = v >> 6, cv = v & 63; u32x4 val = (u32x4){0u, 0u, 0u, 0u};
        if (s0 - 30 + r >= 0) val = *(const u32x4*)(ypre + (size_t)(m0 - 30 + r) * 512 + cv * 8);
        *(LAS u32x4*)(in + r * 512 + cv * 8) = val;
    }
    __syncthreads();
    {
        const int c = tid; const float* cwp = a.in[3]; float cw[31];
#pragma unroll
        for (int w = 0; w < 31; ++w) cw[w] = cwp[w * 512 + c];
        const float cb = a.in[4][c];
        float xin[62];
#pragma unroll
        for (int r = 0; r < 62; ++r) xin[r] = bf2f(in[r * 512 + c]);
#pragma unroll
        for (int tt = 0; tt < 32; ++tt) { float s = cb;
#pragma unroll
            for (int w = 0; w < 31; ++w) s += xin[tt + w] * cw[w];
            outf[tt * 512 + c] = s; }
    }
    __syncthreads();
    {
        const float* g = a.in[5]; const float* b = a.in[6];
        const f32x4 g0 = *(const f32x4*)(g + 4 * lane), g1 = *(const f32x4*)(g + 256 + 4 * lane), b0 = *(const f32x4*)(b + 4 * lane), b1 = *(const f32x4*)(b + 256 + 4 * lane);
        for (int tt = wid; tt < 32; tt += 8) {
            f32x4 v0 = *(const LAS f32x4*)(outf + tt * 512 + 4 * lane), v1 = *(const LAS f32x4*)(outf + tt * 512 + 256 + 4 * lane);
            float s = (v0[0] + v0[1]) + (v0[2] + v0[3]) + (v1[0] + v1[1]) + (v1[2] + v1[3]);
            const float mean = wave_sum(s) * (1.0f / 512.0f);
            v0 -= mean; v1 -= mean;
            float q = v0[0] * v0[0] + v0[1] * v0[1] + v0[2] * v0[2] + v0[3] * v0[3] + v1[0] * v1[0] + v1[1] * v1[1] + v1[2] * v1[2] + v1[3] * v1[3];
            const float rstd = rsqrtf(wave_sum(q) * (1.0f / 512.0f) + 1e-5f);
            v0 = v0 * rstd * g0 + b0; v1 = v1 * rstd * g1 + b1;
#pragma unroll
            for (int j = 0; j < 4; ++j) { v0[j] = v0[j] * sigmoidf_(v0[j]); v1[j] = v1[j] * sigmoidf_(v1[j]); }
            bf16_t* o = mixed + (size_t)(m0 + tt) * DM;
            *(u32x2*)(o + 4 * lane) = pack4(v0); *(u32x2*)(o + 256 + 4 * lane) = pack4(v1);
        }
    }
    __syncthreads();
}
__device__ void sgu_item(const Args& a, LAS unsigned char* lds, int item) {
    LAS bf16_t* Wl = (LAS bf16_t*)lds;
    LAS bf16_t* VT = (LAS bf16_t*)(lds + 34816);
    LAS float* st = (LAS float*)(lds + 69632);
    const bf16_t* ug = (const bf16_t*)(a.ws + SLOTP(1) + 16 * MiB);
    const bf16_t* vg = (const bf16_t*)(a.ws + SLOTP(2));
    bf16_t* mixed = (bf16_t*)(a.ws + SLOTP(3));
    const int tid = tid_opaque(), wid = tid >> 6, lane = tid & 63;
    const int g = item & 3, m0 = (item >> 2) * 128;
    for (int i = 0; i < 16; ++i) {
        const int tok = 16 * wid + i; float f[8]; unpack8(*(const u32x4*)(vg + (size_t)(m0 + tok) * 512 + lane * 8), f);
        float s = 0.f;
#pragma unroll
        for (int e = 0; e < 8; ++e) s += f[e];
        const float mean = wave_sum(s) * (1.0f / 512.0f); float q = 0.f;
#pragma unroll
        for (int e = 0; e < 8; ++e) { const float d = f[e] - mean; q += d * d; }
        const float rstd = rsqrtf(wave_sum(q) * (1.0f / 512.0f) + 1e-5f);
        if (lane == 0) { st[2 * tok] = mean; st[2 * tok + 1] = rstd; }
    }
    __syncthreads();
    {
        const int s = tid & 127, dq = tid >> 7; const float mean = st[2 * s], rstd = st[2 * s + 1];
        const float* sg = a.in[7] + g * 128; const float* sb = a.in[8] + g * 128;
#pragma unroll
        for (int i = 0; i < 4; ++i) {
            const int d0 = (dq * 4 + i) * 8; float f[8]; unpack8(*(const u32x4*)(vg + (size_t)(m0 + s) * 512 + g * 128 + d0), f);
#pragma unroll
            for (int e = 0; e < 8; ++e) VT[(d0 + e) * 136 + s] = f2bf((f[e] - mean) * rstd * sg[d0 + e] + sb[d0 + e]);
        }
        const float* W = a.in[9] + (size_t)g * 128 * 128;
        for (int idx = tid; idx < 128 * 32; idx += 512) {
            const int t = idx >> 5, s4 = (idx & 31) * 4; f32x4 w = *(const f32x4*)(W + t * 128 + s4);
#pragma unroll
            for (int e = 0; e < 4; ++e) if (s4 + e > t) w[e] = 0.f;
            *(LAS u32x2*)(Wl + t * 136 + s4) = pack4(w);
        }
    }
    __syncthreads();
    {
        const int t0 = 16 * wid, row = lane & 15, quad = lane >> 4;
        f32x4 acc[8];
#pragma unroll
        for (int db = 0; db < 8; ++db) acc[db] = (f32x4){0.f, 0.f, 0.f, 0.f};
        for (int s0 = 0; s0 < t0 + 16; s0 += 32) {
            const bf16x8 av = *(const LAS bf16x8*)(Wl + (t0 + row) * 136 + s0 + quad * 8);
#pragma unroll
            for (int db = 0; db < 8; ++db) { const bf16x8 bv = *(const LAS bf16x8*)(VT + (db * 16 + row) * 136 + s0 + quad * 8);
                acc[db] = __builtin_amdgcn_mfma_f32_16x16x32_bf16(av, bv, acc[db], 0, 0, 0); }
        }
        const float* sbias = a.in[10] + g * 128;
#pragma unroll
        for (int db = 0; db < 8; ++db)
#pragma unroll
            for (int j = 0; j < 4; ++j) {
                const int t = t0 + quad * 4 + j, d = db * 16 + row; const float sv = acc[db][j] + sbias[t];
                const float uv = bf2f(ug[(size_t)(m0 + t) * 512 + g * 128 + d]);
                mixed[(size_t)(m0 + t) * DM + 512 + g * 128 + d] = f2bf(uv * sv);
            }
    }
    __syncthreads();
}

struct Row16 { f32x4 v[4]; };
__device__ __forceinline__ void row_load(const float* p, int lane, Row16& r) {
#pragma unroll
    for (int i = 0; i < 4; ++i) r.v[i] = *(const f32x4*)(p + 256 * i + 4 * lane);
}
__device__ __forceinline__ void row_ln(Row16& r, const Row16& g, const Row16& b) {
    float s = 0.f;
#pragma unroll
    for (int i = 0; i < 4; ++i) s += (r.v[i][0] + r.v[i][1]) + (r.v[i][2] + r.v[i][3]);
    const float mean = wave_sum(s) * (1.0f / 1024.0f); float q = 0.f;
#pragma unroll
    for (int i = 0; i < 4; ++i) { r.v[i] -= mean; q += r.v[i][0] * r.v[i][0] + r.v[i][1] * r.v[i][1] + r.v[i][2] * r.v[i][2] + r.v[i][3] * r.v[i][3]; }
    const float rstd = rsqrtf(wave_sum(q) * (1.0f / 1024.0f) + 1e-5f);
#pragma unroll
    for (int i = 0; i < 4; ++i) r.v[i] = r.v[i] * rstd * g.v[i] + b.v[i];
}
__device__ __forceinline__ void row_store_bf(bf16_t* p, int lane, const Row16& r) {
#pragma unroll
    for (int i = 0; i < 4; ++i) *(u32x2*)(p + 256 * i + 4 * lane) = pack4(r.v[i]);
}
__device__ void ln_phase(const float* src, float* dstf, bf16_t* dstb, const float* gp, const float* bp) {
    const int tid = tid_opaque(); const int lane = tid & 63, gw = blockIdx.x * 8 + (tid >> 6), nw = gridDim.x * 8;
    Row16 g, b; row_load(gp, lane, g); row_load(bp, lane, b);
    for (int row = gw; row < MT; row += nw) {
        Row16 r; row_load(src + (size_t)row * DM, lane, r); row_ln(r, g, b);
#pragma unroll
        for (int i = 0; i < 4; ++i) *(f32x4*)(dstf + (size_t)row * DM + 256 * i + 4 * lane) = r.v[i];
        if (dstb) row_store_bf(dstb + (size_t)row * DM, lane, r);
    }
}
__device__ void ln_shift_phase(const Args& a) {
    const float* src = (const float*)(a.ws + SLOTP(4)); float* xf = a.out;
    bf16_t* xr = (bf16_t*)(a.ws + SLOTP(0)); bf16_t* xk = (bf16_t*)(a.ws + SLOTP(1)); bf16_t* xv = (bf16_t*)(a.ws + SLOTP(2)); bf16_t* xg = (bf16_t*)(a.ws + SLOTP(3));
    const int tid = tid_opaque(); const int lane = tid & 63, gw = blockIdx.x * 8 + (tid >> 6), nw = gridDim.x * 8;
    Row16 g, b, mr, mk, mv; row_load(a.in[33], lane, g); row_load(a.in[34], lane, b);
    row_load(a.in[13], lane, mr); row_load(a.in[13] + 2 * 1024, lane, mk); row_load(a.in[13] + 3 * 1024, lane, mv);
    for (int ch = gw; ch < MT / 8; ch += nw) {
        const int r0 = ch * 8; Row16 prev;
        if ((r0 & (SEQL - 1)) == 0) {
#pragma unroll
            for (int i = 0; i < 4; ++i) prev.v[i] = (f32x4){0.f, 0.f, 0.f, 0.f};
        } else { row_load(src + (size_t)(r0 - 1) * DM, lane, prev); row_ln(prev, g, b); }
        for (int r = r0; r < r0 + 8; ++r) {
            Row16 cur; row_load(src + (size_t)r * DM, lane, cur); row_ln(cur, g, b);
#pragma unroll
            for (int i = 0; i < 4; ++i) *(f32x4*)(xf + (size_t)r * DM + 256 * i + 4 * lane) = cur.v[i];
            row_store_bf(xg + (size_t)r * DM, lane, cur);
            Row16 t;
#pragma unroll
            for (int i = 0; i < 4; ++i) t.v[i] = cur.v[i] + (prev.v[i] - cur.v[i]) * mr.v[i];
            row_store_bf(xr + (size_t)r * DM, lane, t);
#pragma unroll
            for (int i = 0; i < 4; ++i) t.v[i] = cur.v[i] + (prev.v[i] - cur.v[i]) * mk.v[i];
            row_store_bf(xk + (size_t)r * DM, lane, t);
#pragma unroll
            for (int i = 0; i < 4; ++i) t.v[i] = cur.v[i] + (prev.v[i] - cur.v[i]) * mv.v[i];
            row_store_bf(xv + (size_t)r * DM, lane, t);
            prev = cur;
        }
    }
}

__device__ void hid_phase(const Args& a) {
    const bf16_t* pq = (const bf16_t*)(a.ws + O_W1T); bf16_t* hid = (bf16_t*)(a.ws + O_HID);
    const int t0 = tid_opaque();
    for (int idx = blockIdx.x * 512 + t0; idx < MT * 64; idx += gridDim.x * 512) {
        const int m = idx >> 6, c4 = (idx & 63) * 4;
        const u32x2 q = *(const u32x2*)(pq + (size_t)m * 512 + c4);
        u32x2 p = (u32x2){0u, 0u}; if (m & (SEQL - 1)) p = *(const u32x2*)(pq + (size_t)(m - 1) * 512 + 256 + c4);
        f32x4 v; v[0] = __uint_as_float(q.x << 16) + __uint_as_float(p.x << 16); v[1] = __uint_as_float(q.x & 0xffff0000u) + __uint_as_float(p.x & 0xffff0000u);
        v[2] = __uint_as_float(q.y << 16) + __uint_as_float(p.y << 16); v[3] = __uint_as_float(q.y & 0xffff0000u) + __uint_as_float(p.y & 0xffff0000u);
        if (c4 < 64) {
#pragma unroll
            for (int j = 0; j < 4; ++j) v[j] = 2.0f * sigmoidf_(2.0f * v[j]) - 1.0f;
        } else if (c4 >= 128) {
#pragma unroll
            for (int j = 0; j < 4; ++j) v[j] = sigmoidf_(v[j]);
        }
        *(u32x2*)(hid + (size_t)m * 256 + c4) = pack4(v);
    }
}

constexpr int TC = 32, SBUF = (5 * TC * 64 + TC * 16) * 4;
__device__ void scan_phase(const Args& a, LAS unsigned char* lds) {
    const bf16_t* rp = (const bf16_t*)(a.ws + SLOTP(4)); const bf16_t* kp = (const bf16_t*)(a.ws + SLOTP(5)); const bf16_t* vp = (const bf16_t*)(a.ws + SLOTP(0));
    const bf16_t* ep = (const bf16_t*)(a.ws + SLOTP(1)); const bf16_t* ap = (const bf16_t*)(a.ws + SLOTP(2));
    bf16_t* yraw = (bf16_t*)(a.ws + SLOTP(3)); float* ct = (float*)(a.ws + O_CT);
    const int tid = tid_opaque(), wid = tid >> 6, lane = tid & 63;
    for (int item = blockIdx.x; item < 256; item += gridDim.x) {
        const int xcd = item & 7, slot = item >> 3, hg = xcd * 8 + (slot >> 2), q = slot & 3, bb = hg >> 4, h = hg & 15;
        const size_t mbase = (size_t)bb * SEQL;
        const int col = h * 64 + lane;
        const float kkc = a.in[23][col], kac = a.in[24][col], rkc = a.in[25][col], omk = 1.0f - kac;
        auto stage = [&](int c, int bufi) {
            LAS float* B = (LAS float*)(lds + bufi * SBUF);
            const int sw = wid - 4;
            float rr[8], kk[8], vv[8], ee[8], aa[8];
#pragma unroll
            for (int i = 0; i < 8; ++i) { const size_t idx = (mbase + c * TC + sw * 8 + i) * DM + col;
                rr[i] = bf2f(rp[idx]); kk[i] = bf2f(kp[idx]); vv[i] = bf2f(vp[idx]); ee[i] = bf2f(ep[idx]); aa[i] = bf2f(ap[idx]); }
#pragma unroll
            for (int i = 0; i < 8; ++i) {
                const int tl = sw * 8 + i;
                const float kkr = kk[i] * kkc; const float ss = wave_sum(kkr * kkr); const float inv = __builtin_amdgcn_rsqf(fmaxf(ss, 1e-24f));
                const float nkk = -kkr * inv; const float kpr = kk[i] * (aa[i] * kac + omk);
                B[0 * TC * 64 + tl * 64 + lane] = __expf(-ee[i]);
                B[1 * TC * 64 + tl * 64 + lane] = nkk;
                B[2 * TC * 64 + tl * 64 + lane] = -nkk * aa[i];
                B[3 * TC * 64 + tl * 64 + lane] = kpr;
                B[4 * TC * 64 + tl * 64 + lane] = rr[i];
                if ((lane >> 4) == q) B[5 * TC * 64 + tl * 16 + (lane & 15)] = vv[i];
                if (q == 0) { const float cterm = wave_sum(rr[i] * kpr * rkc); if (lane == 0) ct[(mbase + c * TC + tl) * 16 + h] = cterm; }
            }
        };
        if (wid >= 4) stage(0, 0);
        __syncthreads();
        f32x2 S0 = (f32x2){0.f, 0.f}, S1 = (f32x2){0.f, 0.f};
        const int il = lane >> 4, jl = lane & 15, rowl = 4 * (wid & 3) + il;
        for (int c = 0; c < SEQL / TC; ++c) {
            if (wid >= 4) { if (c + 1 < SEQL / TC) stage(c + 1, (c + 1) & 1); }
            else {
                const LAS float* B = (const LAS float*)(lds + (c & 1) * SBUF);
                bf16_t* yo = yraw + (mbase + c * TC + jl) * DM + h * 64 + 16 * q + rowl;
#pragma unroll
                for (int t16 = 0; t16 < TC; t16 += 16) {
                    float ykeep = 0.f;
#pragma unroll
                    for (int ts = 0; ts < 16; ++ts) {
                        const int tl = t16 + ts;
                        const f32x4 w4 = *(const LAS f32x4*)(B + 0 * TC * 64 + tl * 64 + 4 * jl), n4 = *(const LAS f32x4*)(B + 1 * TC * 64 + tl * 64 + 4 * jl),
                                    b4 = *(const LAS f32x4*)(B + 2 * TC * 64 + tl * 64 + 4 * jl), k4 = *(const LAS f32x4*)(B + 3 * TC * 64 + tl * 64 + 4 * jl),
                                    r4 = *(const LAS f32x4*)(B + 4 * TC * 64 + tl * 64 + 4 * jl);
                        const float vi = B[5 * TC * 64 + tl * 16 + rowl];
                        const f32x2 vi2 = (f32x2){vi, vi};
                        const f32x2 p = S0 * (f32x2){n4[0], n4[1]} + S1 * (f32x2){n4[2], n4[3]};
                        const float sa = red16(p[0] + p[1]);
                        const f32x2 sa2 = (f32x2){sa, sa};
                        S0 = S0 * (f32x2){w4[0], w4[1]} + (f32x2){k4[0], k4[1]} * vi2;
                        S1 = S1 * (f32x2){w4[2], w4[3]} + (f32x2){k4[2], k4[3]} * vi2;
                        S0 = (f32x2){b4[0], b4[1]} * sa2 + S0;
                        S1 = (f32x2){b4[2], b4[3]} * sa2 + S1;
                        const f32x2 yy = S0 * (f32x2){r4[0], r4[1]} + S1 * (f32x2){r4[2], r4[3]};
                        const float y = red16(yy[0] + yy[1]);
                        ykeep = (jl == ts) ? y : ykeep;
                    }
                    yo[(size_t)t16 * DM] = f2bf(ykeep);
                }
            }
            __syncthreads();
        }
    }
}
__device__ void post_phase(const Args& a) {
    const bf16_t* yraw = (const bf16_t*)(a.ws + SLOTP(3)); const bf16_t* vp = (const bf16_t*)(a.ws + SLOTP(0)); const bf16_t* gg = (const bf16_t*)(a.ws + SLOTP(4));
    const float* ct = (const float*)(a.ws + O_CT); bf16_t* yb = (bf16_t*)(a.ws + SLOTP(5));
    const int tid = tid_opaque(); const int lane = tid & 63, gw = blockIdx.x * 8 + (tid >> 6), nw = gridDim.x * 8;
    const int c0 = 16 * lane;
    float lg[16], lb[16];
#pragma unroll
    for (int i = 0; i < 16; ++i) { lg[i] = a.in[26][c0 + i]; lb[i] = a.in[27][c0 + i]; }
    for (int row = gw; row < MT; row += nw) {
        const size_t o = (size_t)row * DM + c0; float y[16], v[16], g[16];
        unpack8(*(const u32x4*)(yraw + o), *(float(*)[8])&y[0]); unpack8(*(const u32x4*)(yraw + o + 8), *(float(*)[8])&y[8]);
        unpack8(*(const u32x4*)(vp + o), *(float(*)[8])&v[0]); unpack8(*(const u32x4*)(vp + o + 8), *(float(*)[8])&v[8]);
        unpack8(*(const u32x4*)(gg + o), *(float(*)[8])&g[0]); unpack8(*(const u32x4*)(gg + o + 8), *(float(*)[8])&g[8]);
        const float cv = ct[(size_t)row * 16 + (lane >> 2)];
        float s = 0.f;
#pragma unroll
        for (int i = 0; i < 16; ++i) s += y[i];
        s += dpp_mov<0xB1>(s); s += dpp_mov<0x4E>(s);
        const float mean = s * (1.0f / 64.0f); float qq = 0.f;
#pragma unroll
        for (int i = 0; i < 16; ++i) { y[i] -= mean; qq += y[i] * y[i]; }
        qq += dpp_mov<0xB1>(qq); qq += dpp_mov<0x4E>(qq);
        const float rstd = rsqrtf(qq * (1.0f / 64.0f) + 64e-5f);
        u32x4 w0, w1; float of[16];
#pragma unroll
        for (int i = 0; i < 16; ++i) of[i] = (y[i] * rstd * lg[i] + lb[i] + cv * v[i]) * g[i];
#pragma unroll
        for (int i = 0; i < 4; ++i) { w0[i] = cvt_pk_bf16(of[2 * i], of[2 * i + 1]); w1[i] = cvt_pk_bf16(of[8 + 2 * i], of[8 + 2 * i + 1]); }
        *(u32x4*)(yb + o) = w0; *(u32x4*)(yb + o + 8) = w1;
    }
}

constexpr int NPHASE = 19;
__global__ void __launch_bounds__(512, 2) mk_fwd(Args a) {
    extern __shared__ __attribute__((aligned(16))) unsigned char smem[];
    LAS unsigned char* lds = (LAS unsigned char*)smem;
    cg::grid_group grid = cg::this_grid();
    unsigned char* ws = a.ws;
#define BFP(off) ((bf16_t*)(ws + (off)))
    if (a.ph_lo <= 0 && 0 < a.ph_hi) { if (ONLY < 0 || ONLY == 0) { for (int rep_ = 0; rep_ < (DUP == 0 ? 2 : 1); ++rep_) { if (rep_) grid.sync(); prep_phase(a, lds); } }
        if (0 + 1 < a.ph_hi) grid.sync(); }
    if (a.ph_lo <= 1 && 1 < a.ph_hi) { if (ONLY < 0 || ONLY == 1) { for (int rep_ = 0; rep_ < (DUP == 1 ? 2 : 1); ++rep_) { if (rep_) grid.sync(); { StaticOrder S{64, 8, 2048, 2048}; EpiG1 E{BFP(SLOTP(1)), BFP(SLOTP(1) + 16 * MiB), BFP(SLOTP(2)), a.in[2]};
            gemm_phase(lds, BFP(SLOTP(0)), BFP(O_W1T), 1024, 2048, S, E); } } }
        if (1 + 1 < a.ph_hi) grid.sync(); }
    if (a.ph_lo <= 2 && 2 < a.ph_hi) { if (ONLY < 0 || ONLY == 2) { for (int rep_ = 0; rep_ < (DUP == 2 ? 2 : 1); ++rep_) { if (rep_) grid.sync(); { for (int t = blockIdx.x; t < 512; t += gridDim.x) conv_tile(a, lds, t);
            for (int t = blockIdx.x; t < 512; t += gridDim.x) sgu_item(a, lds, t); } } }
        if (2 + 1 < a.ph_hi) grid.sync(); }
    if (a.ph_lo <= 3 && 3 < a.ph_hi) { if (ONLY < 0 || ONLY == 3) { for (int rep_ = 0; rep_ < (DUP == 3 ? 2 : 1); ++rep_) { if (rep_) grid.sync(); { StaticOrder S{64, 4, 2048, 2048}; EpiRes E{a.in[0], a.out, a.in[12]}; gemm_phase(lds, BFP(SLOTP(3)), BFP(O_W2T), 1024, 2048, S, E); } } }
        if (3 + 1 < a.ph_hi) grid.sync(); }
    if (a.ph_lo <= 4 && 4 < a.ph_hi) { if (ONLY < 0 || ONLY == 4) { for (int rep_ = 0; rep_ < (DUP == 4 ? 2 : 1); ++rep_) { if (rep_) grid.sync(); ln_phase(a.out, a.out, BFP(SLOTP(0)), a.in[31], a.in[32]); } }
        if (4 + 1 < a.ph_hi) grid.sync(); }
    if (a.ph_lo <= 5 && 5 < a.ph_hi) { if (ONLY < 0 || ONLY == 5) { for (int rep_ = 0; rep_ < (DUP == 5 ? 2 : 1); ++rep_) { if (rep_) grid.sync(); { StaticOrder S{64, 22, 2048, 2048}; EpiSwiglu E{BFP(SLOTP(1))}; gemm_phase(lds, BFP(SLOTP(0)), BFP(O_F1T0), 1024, 2048, S, E); } } }
        if (5 + 1 < a.ph_hi) grid.sync(); }
    if (a.ph_lo <= 6 && 6 < a.ph_hi) { if (ONLY < 0 || ONLY == 6) { for (int rep_ = 0; rep_ < (DUP == 6 ? 2 : 1); ++rep_) { if (rep_) grid.sync(); { StaticOrder S{64, 4, 2 * FH, 2 * FH}; EpiRes E{a.out, (float*)(ws + SLOTP(4)), nullptr}; gemm_phase(lds, BFP(SLOTP(1)), BFP(O_F2T0), FH, 2 * FH, S, E); } } }
        if (6 + 1 < a.ph_hi) grid.sync(); }
    if (a.ph_lo <= 7 && 7 < a.ph_hi) { if (ONLY < 0 || ONLY == 7) { for (int rep_ = 0; rep_ < (DUP == 7 ? 2 : 1); ++rep_) { if (rep_) grid.sync(); ln_shift_phase(a); } }
        if (7 + 1 < a.ph_hi) grid.sync(); }
    if (a.ph_lo <= 8 && 8 < a.ph_hi) { if (ONLY < 0 || ONLY == 8) { for (int rep_ = 0; rep_ < (DUP == 8 ? 2 : 1); ++rep_) { if (rep_) grid.sync(); { StaticOrder S2{64, 2, 2048, 2048}; EpiBf<3> E2{BFP(O_W1T), nullptr, 0, nullptr, nullptr}; gemm_phase(lds, BFP(SLOTP(3)), BFP(O_WL1), 1024, 2048, S2, E2);
            GroupOrder S{2, SLOT}; EpiBf<0> E{BFP(SLOTP(4)), nullptr, SLOT / 2, nullptr, nullptr}; gemm_phase(lds, BFP(SLOTP(0)), BFP(O_WRKV), 1024, 2048, S, E); } } }
        if (8 + 1 < a.ph_hi) grid.sync(); }
    if (a.ph_lo <= 9 && 9 < a.ph_hi) { if (ONLY < 0 || ONLY == 9) { for (int rep_ = 0; rep_ < (DUP == 9 ? 2 : 1); ++rep_) { if (rep_) grid.sync(); { StaticOrder S{64, 4, 2048, 2048}; EpiBf<0> E{BFP(SLOTP(0)), nullptr, 0, nullptr, nullptr}; gemm_phase(lds, BFP(SLOTP(2)), BFP(O_WRKV + 4 * MiB), 1024, 2048, S, E); hid_phase(a); } } }
        if (9 + 1 < a.ph_hi) grid.sync(); }
    if (a.ph_lo <= 10 && 10 < a.ph_hi) { if (ONLY < 0 || ONLY == 10) { for (int rep_ = 0; rep_ < (DUP == 10 ? 2 : 1); ++rep_) { if (rep_) grid.sync(); { StaticOrder S{64, 4, 512, 512}; EpiBf<2> E{BFP(SLOTP(1)), nullptr, 0, a.in[15], nullptr}; gemm_phase(lds, BFP(O_HID), BFP(O_L2T), 256, 512, S, E);
            EpiBf<4> E2{BFP(SLOTP(2)), nullptr, 0, a.in[18], nullptr}; gemm_phase(lds, BFP(O_HID), BFP(O_L2T + 512 * 1024), 256, 512, S, E2); } } }
        if (10 + 1 < a.ph_hi) grid.sync(); }
    if (a.ph_lo <= 11 && 11 < a.ph_hi) { if (ONLY < 0 || ONLY == 11) { for (int rep_ = 0; rep_ < (DUP == 11 ? 2 : 1); ++rep_) { if (rep_) grid.sync(); scan_phase(a, lds); } }
        if (11 + 1 < a.ph_hi) grid.sync(); }
    if (a.ph_lo <= 12 && 12 < a.ph_hi) { if (ONLY < 0 || ONLY == 12) { for (int rep_ = 0; rep_ < (DUP == 12 ? 2 : 1); ++rep_) { if (rep_) grid.sync(); { StaticOrder S{64, 4, 512, 512}; EpiBf<0> E{BFP(SLOTP(4)), nullptr, 0, nullptr, nullptr}; gemm_phase(lds, BFP(O_HID), BFP(O_L2T + 1 * MiB), 256, 512, S, E); } } }
        if (12 + 1 < a.ph_hi) grid.sync(); }
    if (a.ph_lo <= 13 && 13 < a.ph_hi) { if (ONLY < 0 || ONLY == 13) { for (int rep_ = 0; rep_ < (DUP == 13 ? 2 : 1); ++rep_) { if (rep_) grid.sync(); post_phase(a); } }
        if (13 + 1 < a.ph_hi) grid.sync(); }
    if (a.ph_lo <= 14 && 14 < a.ph_hi) { if (ONLY < 0 || ONLY == 14) { for (int rep_ = 0; rep_ < (DUP == 14 ? 2 : 1); ++rep_) { if (rep_) grid.sync(); { StaticOrder S{64, 4, 2048, 2048}; EpiRes E{a.out, a.out, nullptr}; gemm_phase(lds, BFP(SLOTP(5)), BFP(O_WOT), 1024, 2048, S, E); } } }
        if (14 + 1 < a.ph_hi) grid.sync(); }
    if (a.ph_lo <= 15 && 15 < a.ph_hi) { if (ONLY < 0 || ONLY == 15) { for (int rep_ = 0; rep_ < (DUP == 15 ? 2 : 1); ++rep_) { if (rep_) grid.sync(); ln_phase(a.out, a.out, BFP(SLOTP(0)), a.in[31] + 1024, a.in[32] + 1024); } }
        if (15 + 1 < a.ph_hi) grid.sync(); }
    if (a.ph_lo <= 16 && 16 < a.ph_hi) { if (ONLY < 0 || ONLY == 16) { for (int rep_ = 0; rep_ < (DUP == 16 ? 2 : 1); ++rep_) { if (rep_) grid.sync(); { StaticOrder S{64, 22, 2048, 2048}; EpiSwiglu E{BFP(SLOTP(1))}; gemm_phase(lds, BFP(SLOTP(0)), BFP(O_F1T1), 1024, 2048, S, E); } } }
        if (16 + 1 < a.ph_hi) grid.sync(); }
    if (a.ph_lo <= 17 && 17 < a.ph_hi) { if (ONLY < 0 || ONLY == 17) { for (int rep_ = 0; rep_ < (DUP == 17 ? 2 : 1); ++rep_) { if (rep_) grid.sync(); { StaticOrder S{64, 4, 2 * FH, 2 * FH}; EpiRes E{a.out, a.out, nullptr}; gemm_phase(lds, BFP(SLOTP(1)), BFP(O_F2T1), FH, 2 * FH, S, E); } } }
        if (17 + 1 < a.ph_hi) grid.sync(); }
    if (a.ph_lo <= 18 && 18 < a.ph_hi) { if (ONLY < 0 || ONLY == 18) { for (int rep_ = 0; rep_ < (DUP == 18 ? 2 : 1); ++rep_) { if (rep_) grid.sync(); ln_phase(a.out, a.out, nullptr, a.in[33] + 1024, a.in[34] + 1024); } }
        if (18 + 1 < a.ph_hi) grid.sync(); }
    if (a.ph_lo <= 19 && 19 < a.ph_hi) { const bf16_t* src = BFP(DUMP_OFF); const int t0 = tid_opaque();
        for (size_t i = (size_t)blockIdx.x * 512 + t0; i < (size_t)MT * DM; i += (size_t)gridDim.x * 512) a.out[i] = bf2f(src[i]); }
#undef BFP
}

extern "C" void kernel_launch(void* const* d_in, const int* in_sizes, int n_in, void* d_out, int out_size, void* d_ws, size_t ws_size, hipStream_t stream) {
    static int grid_blocks = 0;
    if (grid_blocks == 0) {
        if (n_in != 35 || out_size != MT * DM || ws_size < WS_END) { fprintf(stderr, "kernel_launch: unexpected shapes (n_in %d out %d ws %zu need %zu)\n", n_in, out_size, ws_size, (size_t)WS_END); grid_blocks = -1; return; }
        int dev = 0, cus = 0, per_cu = 0;
        hipGetDevice(&dev); hipDeviceGetAttribute(&cus, hipDeviceAttributeMultiprocessorCount, dev);
        hipFuncSetAttribute((const void*)mk_fwd, hipFuncAttributeMaxDynamicSharedMemorySize, STAGE_BYTES);
        hipOccupancyMaxActiveBlocksPerMultiprocessor(&per_cu, (const void*)mk_fwd, 512, STAGE_BYTES);
        if (per_cu < 1) per_cu = 1;
        grid_blocks = cus * per_cu;
        if (grid_blocks > 256) grid_blocks = 256;
    }
    if (grid_blocks < 0) return;
    Args a{};
    for (int i = 0; i < 35; ++i) a.in[i] = (const float*)d_in[i];
    a.out = (float*)d_out; a.ws = (unsigned char*)d_ws;
#if PER_PHASE_LAUNCH
    for (int ph = 0; ph < NPHASE && ph <= STOP_AFTER; ++ph) {
        a.ph_lo = ph; a.ph_hi = ph + 1; void* args[] = {&a};
        hipError_t e = hipLaunchCooperativeKernel((const void*)mk_fwd, dim3(grid_blocks), dim3(512), args, STAGE_BYTES, stream);
        if (e != hipSuccess) { fprintf(stderr, "cooperative launch failed: %s\n", hipGetErrorString(e)); return; }
    }
    if (STOP_AFTER < NPHASE - 1) { a.ph_lo = 19; a.ph_hi = 20; void* args[] = {&a};
        (void)hipLaunchCooperativeKernel((const void*)mk_fwd, dim3(grid_blocks), dim3(512), args, STAGE_BYTES, stream); }
#else
    a.ph_lo = 0; a.ph_hi = NPHASE; void* args[] = {&a};
    hipError_t e = hipLaunchCooperativeKernel((const void*)mk_fwd, dim3(grid_blocks), dim3(512), args, STAGE_BYTES, stream);
    if (e != hipSuccess) fprintf(stderr, "cooperative launch failed: %s (grid %d)\n", hipGetErrorString(e), grid_blocks);
#endif
}
```

```cpp
#include <hip/hip_runtime.h>
#include <hip/hip_cooperative_groups.h>
#include <cstdio>
namespace cg = cooperative_groups;

#ifndef PER_PHASE_LAUNCH
#define PER_PHASE_LAUNCH 0
#endif

#ifndef STOP_AFTER
#define STOP_AFTER 99
#endif
#ifndef DUMP_OFF
#define DUMP_OFF SLOTP(2)
#endif
#ifndef DUP
#define DUP -1
#endif
#ifndef ONLY
#define ONLY -1
#endif
#define LAS __attribute__((address_space(3)))
typedef unsigned short bf16_t;
typedef short bf16x8 __attribute__((ext_vector_type(8)));
typedef float f32x4 __attribute__((ext_vector_type(4)));
typedef unsigned u32x4 __attribute__((ext_vector_type(4)));
typedef unsigned u32x2 __attribute__((ext_vector_type(2)));

constexpr int MT = 16384, DM = 1024, SEQL = 4096, FH = 2816;
constexpr float ALPHA = 1.41421356237f;
constexpr size_t MiB = 1ull << 20;
constexpr size_t O_WRKV = 0;
constexpr size_t O_WL1 = 6 * MiB;
constexpr size_t O_L2T = 7 * MiB;
constexpr size_t O_WOT = 8 * MiB + 512 * 1024;
constexpr size_t O_F1T1 = 10 * MiB + 512 * 1024;
constexpr size_t O_F2T1 = 21 * MiB + 512 * 1024;
constexpr size_t O_W1T = 27 * MiB;
constexpr size_t O_W2T = 31 * MiB;
constexpr size_t O_F1T0 = 33 * MiB;
constexpr size_t O_F2T0 = 44 * MiB;
constexpr size_t O_CT = 50 * MiB;
constexpr size_t O_BAR = 51 * MiB;
constexpr size_t O_SLOT = 52 * MiB;
constexpr size_t SLOT = 32 * MiB + 64 * 1024;
constexpr size_t O_HID = O_SLOT + 6 * SLOT;
constexpr size_t WS_END = O_HID + 8 * MiB;
#define SLOTP(i) (O_SLOT + (size_t)(i) * SLOT)

struct Args { const float* in[35]; float* out; unsigned char* ws; int ph_lo, ph_hi; };

__device__ __forceinline__ float bf2f(bf16_t v) { return __uint_as_float((unsigned)v << 16); }
typedef float f32x2 __attribute__((ext_vector_type(2)));
typedef __bf16 bf16x2n __attribute__((ext_vector_type(2)));
__device__ __forceinline__ unsigned cvt_pk_bf16(float lo, float hi) { const f32x2 v = {lo, hi}; return __builtin_bit_cast(unsigned, __builtin_convertvector(v, bf16x2n)); }
__device__ __forceinline__ bf16_t f2bf(float f) { return (bf16_t)(cvt_pk_bf16(f, 0.f) & 0xffffu); }
__device__ __forceinline__ float sigmoidf_(float z) { return __builtin_amdgcn_rcpf(1.0f + __expf(-z)); }
__device__ __forceinline__ float gelu_tanh(float x) { return x * sigmoidf_(1.5957691216f * (x + 0.044715f * x * x * x)); }
__device__ __forceinline__ int tid_opaque() { int t = threadIdx.x; asm volatile("" : "+v"(t)); return t; }
template <int CTRL> __device__ __forceinline__ float dpp_mov(float v) { return __int_as_float(__builtin_amdgcn_update_dpp(0, __float_as_int(v), CTRL, 0xF, 0xF, true)); }
__device__ __forceinline__ float red16(float v) { v += dpp_mov<0xB1>(v); v += dpp_mov<0x4E>(v); v += dpp_mov<0x141>(v); v += dpp_mov<0x140>(v); return v; }
__device__ __forceinline__ float wave_sum(float v) {
    v = red16(v);
    return ((__int_as_float(__builtin_amdgcn_readlane(__float_as_int(v), 0)) + __int_as_float(__builtin_amdgcn_readlane(__float_as_int(v), 16))) + (__int_as_float(__builtin_amdgcn_readlane(__float_as_int(v), 32)) + __int_as_float(__builtin_amdgcn_readlane(__float_as_int(v), 48))));
}
__device__ __forceinline__ float wave_sum_old(float v) {
#pragma unroll
    for (int o = 32; o; o >>= 1) v += __shfl_xor(v, o);
    return v;
}
__device__ __forceinline__ u32x2 pack4(f32x4 v) { u32x2 w; w.x = cvt_pk_bf16(v[0], v[1]); w.y = cvt_pk_bf16(v[2], v[3]); return w; }
__device__ __forceinline__ void unpack8(u32x4 r, float (&f)[8]) {
#pragma unroll
    for (int i = 0; i < 4; ++i) { f[2 * i] = __uint_as_float(r[i] << 16); f[2 * i + 1] = __uint_as_float(r[i] & 0xffff0000u); }
}

constexpr int BM = 256, BK = 64, HALF = 128, HTB = HALF * BK * 2, STAGE_BYTES = 8 * HTB, NXCD = 8, WGM = 8;
__device__ __forceinline__ int lds_byte(int r, int c) { const int st = (r >> 4) * 2 + (c >> 5), rr = r & 15, cc = c & 31, ob = rr * 64 + cc * 2; return st * 1024 + (ob ^ (((ob >> 9) & 1) << 5)); }
__device__ __forceinline__ void stage_rc(int b, int& R, int& C) { const int st = b / 1024, sb = b % 1024, swz = sb ^ (((sb >> 9) & 1) << 5); R = (st >> 1) * 16 + swz / 64; C = (st & 1) * 32 + (swz % 64) / 2; }

struct Unit { int pm, pn, tag; size_t aoff, boff; };
__device__ __forceinline__ void remap_tile(int wgid, int nM, int nN, int& pm, int& pn) {
    const int nwg = nM * nN;
    { const int q = nwg / NXCD, r = nwg % NXCD, xcd = wgid % NXCD, off = wgid / NXCD; wgid = (xcd < r ? xcd * (q + 1) : r * (q + 1) + (xcd - r) * q) + off; }
    const int nig = WGM * nN, gid = wgid / nig, fm = gid * WGM, gsz = (nM - fm) < WGM ? (nM - fm) : WGM;
    pm = fm + ((wgid % nig) % gsz); pn = (wgid % nig) / gsz;
}
struct StaticOrder {
    int nM, nN; size_t ldaB, ldbB;
    __device__ __forceinline__ bool next(int i, Unit& u) const {
        const long L = (long)i * gridDim.x + blockIdx.x; if (L >= (long)nM * nN) return false;
        remap_tile((int)L, nM, nN, u.pm, u.pn); u.tag = 0; u.aoff = (size_t)u.pm * BM * ldaB; u.boff = (size_t)u.pn * BM * ldbB; return true;
    }
};
struct GroupOrder {
    int ngr; size_t astride;
    __device__ __forceinline__ bool next(int i, Unit& u) const {
        const long L = (long)i * gridDim.x + blockIdx.x; if (L >= (long)ngr * 256) return false;
        const int g = (int)(L >> 8); remap_tile((int)(L & 255), 64, 4, u.pm, u.pn); u.tag = g;
        u.aoff = (size_t)g * astride + (size_t)u.pm * BM * 2048; u.boff = (size_t)(g * 4 + u.pn) * BM * 2048; return true;
    }
};
struct LoraOrder {
    __device__ __forceinline__ bool next(int i, Unit& u) const {
        const long L = (long)i * gridDim.x + blockIdx.x; if (L >= 64) return false;
        u.pm = (int)L; u.pn = 0; u.tag = 0; u.aoff = (size_t)(256 * u.pm + (u.pm >> 4)) * 2048; u.boff = 0; return true;
    }
};

#define EPI_ROWS(ai, m) (u.pm * BM + (ai) * HALF + wr * 64 + (m) * 16 + fr)
#define EPI_CL(n) (wc * 32 + (n) * 16 + 4 * fq)
typedef f32x4 AccT[2][2][4][2];

struct EpiG1 {
    bf16_t* ypre; bf16_t* ug; bf16_t* vg; const float* bias;
    __device__ __forceinline__ void operator()(const AccT& acc, const Unit& u, int wr, int wc, int fr, int fq) const {
        if (u.pn < 4) {
#pragma unroll
            for (int n = 0; n < 2; ++n) {
                const int cl = EPI_CL(n); const f32x4 bv = *(const f32x4*)(bias + 128 * u.pn + cl), bg = *(const f32x4*)(bias + 512 + 128 * u.pn + cl);
#pragma unroll
                for (int ai = 0; ai < 2; ++ai)
#pragma unroll
                    for (int m = 0; m < 4; ++m) { const f32x4 val = acc[ai][0][m][n] + bv, gate = acc[ai][1][m][n] + bg; f32x4 y;
#pragma unroll
                        for (int j = 0; j < 4; ++j) y[j] = val[j] * sigmoidf_(gate[j]);
                        *(u32x2*)(ypre + (size_t)EPI_ROWS(ai, m) * 512 + 128 * u.pn + cl) = pack4(y); }
            }
        } else {
            bf16_t* dst = u.pn < 6 ? ug : vg; const int cb = (u.pn & 1) * 256;
#pragma unroll
            for (int bj = 0; bj < 2; ++bj)
#pragma unroll
                for (int n = 0; n < 2; ++n) {
                    const int cl = bj * HALF + EPI_CL(n); const f32x4 bv = *(const f32x4*)(bias + 256 * u.pn + cl);
#pragma unroll
                    for (int ai = 0; ai < 2; ++ai)
#pragma unroll
                        for (int m = 0; m < 4; ++m) { const f32x4 v = acc[ai][bj][m][n] + bv; f32x4 y;
#pragma unroll
                            for (int j = 0; j < 4; ++j) y[j] = gelu_tanh(v[j]);
                            *(u32x2*)(dst + (size_t)EPI_ROWS(ai, m) * 512 + cb + cl) = pack4(y); }
                }
        }
    }
};
struct EpiRes {
    const float* res; float* out; const float* bias;
    __device__ __forceinline__ void operator()(const AccT& acc, const Unit& u, int wr, int wc, int fr, int fq) const {
#pragma unroll
        for (int bj = 0; bj < 2; ++bj)
#pragma unroll
            for (int n = 0; n < 2; ++n) {
                const int col = u.pn * BM + bj * HALF + EPI_CL(n); const f32x4 bv = bias ? *(const f32x4*)(bias + col) : (f32x4){0.f, 0.f, 0.f, 0.f};
#pragma unroll
                for (int ai = 0; ai < 2; ++ai)
#pragma unroll
                    for (int m = 0; m < 4; ++m) { const size_t off = (size_t)EPI_ROWS(ai, m) * DM + col; const f32x4 r4 = *(const f32x4*)(res + off);
                        *(f32x4*)(out + off) = r4 * ALPHA + acc[ai][bj][m][n] + bv; }
            }
    }
};
struct EpiSwiglu {
    bf16_t* hmid;
    __device__ __forceinline__ void operator()(const AccT& acc, const Unit& u, int wr, int wc, int fr, int fq) const {
#pragma unroll
        for (int n = 0; n < 2; ++n) {
            const int col = 128 * u.pn + EPI_CL(n);
#pragma unroll
            for (int ai = 0; ai < 2; ++ai)
#pragma unroll
                for (int m = 0; m < 4; ++m) { const f32x4 g = acc[ai][0][m][n], up = acc[ai][1][m][n]; f32x4 y;
#pragma unroll
                    for (int j = 0; j < 4; ++j) y[j] = g[j] * sigmoidf_(g[j]) * up[j];
                    *(u32x2*)(hmid + (size_t)EPI_ROWS(ai, m) * FH + col) = pack4(y); }
        }
    }
};
template <int MODE> struct EpiBf {
    bf16_t* dst; bf16_t* dst2; size_t gstride; const float* p0; const float* p1;
    __device__ __forceinline__ void operator()(const AccT& acc, const Unit& u, int wr, int wc, int fr, int fq) const {
#pragma unroll
        for (int bj = 0; bj < 2; ++bj)
#pragma unroll
            for (int n = 0; n < 2; ++n) {
                const int col = u.pn * BM + bj * HALF + EPI_CL(n);
                f32x4 pv = (f32x4){0.f, 0.f, 0.f, 0.f};
                if (MODE == 2 || MODE == 4) pv = *(const f32x4*)(p0 + col);
#pragma unroll
                for (int ai = 0; ai < 2; ++ai)
#pragma unroll
                    for (int m = 0; m < 4; ++m) {
                        const size_t row = (size_t)EPI_ROWS(ai, m); f32x4 v = acc[ai][bj][m][n];
                        if (MODE == 0) { *(u32x2*)(dst + (size_t)u.tag * gstride + row * DM + col) = pack4(v); }
                        if (MODE == 3) { *(u32x2*)(dst + row * 512 + col) = pack4(v); }
                        if (MODE == 1) {
                            if (col < 64) {
#pragma unroll
                                for (int j = 0; j < 4; ++j) v[j] = 2.0f * sigmoidf_(2.0f * v[j]) - 1.0f;
                            } else if (col >= 128) {
#pragma unroll
                                for (int j = 0; j < 4; ++j) v[j] = sigmoidf_(v[j]);
                            }
                            *(u32x2*)(dst + row * 256 + col) = pack4(v);
                        }
                        if (MODE == 2) {
                            v += pv;
#pragma unroll
                            for (int j = 0; j < 4; ++j) v[j] = 0.60653066f * sigmoidf_(v[j]);
                            *(u32x2*)(dst + row * DM + col) = pack4(v);
                        }
                        if (MODE == 4) {
                            v += pv;
#pragma unroll
                            for (int j = 0; j < 4; ++j) v[j] = sigmoidf_(v[j]);
                            *(u32x2*)(dst + row * DM + col) = pack4(v);
                        }
                    }
            }
    }
};

template <class Epi, class Sched>
__device__ __forceinline__ void gemm_phase(LAS unsigned char* lds, const bf16_t* Ap, const bf16_t* Btp, const int K, const size_t ldaB, const Sched& S, const Epi& E) {
    int tid = threadIdx.x; asm volatile("" : "+v"(tid));
    const int wid = __builtin_amdgcn_readfirstlane(tid >> 6), lane = tid & 63, wr = wid >> 2, wc = wid & 3, fr = lane & 15, fq = lane >> 4;
    const int nt = K / BK;
    unsigned voffA[2], voffB[2];
#pragma unroll
    for (int i = 0; i < 2; ++i) { int R, C; stage_rc(tid * 16 + i * 8192, R, C); voffA[i] = (unsigned)(R * (int)ldaB + C * 2); voffB[i] = (unsigned)(R * K + C) * 2u; }
    const size_t kstep = (size_t)(BK * 2);
    const size_t hA = (size_t)HALF * ldaB, hB = (size_t)HALF * K * 2;
    const unsigned ldsw = (unsigned)wid * 1024u;
    const int aoff = lds_byte(wr * 64 + fr, fq * 8), boff = lds_byte(wc * 32 + fr, fq * 8);
#define G_SA(b, h) (((b) * 2 + (h)) * HTB)
#define G_SB(b, h) ((4 + (b) * 2 + (h)) * HTB)
#define G_STAGE(bufoff, gbase, voff) do { _Pragma("unroll") for (int _i = 0; _i < 2; ++_i) \
        __builtin_amdgcn_global_load_lds((const unsigned*)((const char*)(gbase) + (voff)[_i]), (LAS unsigned*)(lds + (bufoff) + ldsw + _i * 8192), 16, 0, 0); } while (0)
#define G_LDA(dst, b, h) do { _Pragma("unroll") for (int m = 0; m < 4; ++m) _Pragma("unroll") for (int k = 0; k < 2; ++k) dst[m][k] = *(const LAS bf16x8*)(lds + G_SA(b, h) + aoff + m * 2048 + k * 1024); } while (0)
#define G_LDB(dst, b, h) do { _Pragma("unroll") for (int n = 0; n < 2; ++n) _Pragma("unroll") for (int k = 0; k < 2; ++k) dst[n][k] = *(const LAS bf16x8*)(lds + G_SB(b, h) + boff + n * 2048 + k * 1024); } while (0)
#define G_MMA(ai, bj, At, Bt) do { __builtin_amdgcn_s_setprio(1); _Pragma("unroll") for (int m = 0; m < 4; ++m) _Pragma("unroll") for (int n = 0; n < 2; ++n) _Pragma("unroll") for (int k = 0; k < 2; ++k) \
        acc[ai][bj][m][n] = __builtin_amdgcn_mfma_f32_16x16x32_bf16(Bt[n][k], At[m][k], acc[ai][bj][m][n], 0, 0, 0); __builtin_amdgcn_s_setprio(0); } while (0)
#define G_WAIT_V(n) asm volatile("s_waitcnt vmcnt(" #n ")" ::: "memory")
#define G_WAIT_L(n) asm volatile("s_waitcnt lgkmcnt(" #n ")" ::: "memory")
#define G_BAR __builtin_amdgcn_s_barrier()
#define G_SCHED __builtin_amdgcn_sched_barrier(0)
    Unit cur, nxt; int ui = 0;
    if (!S.next(0, cur)) return;
    f32x4 acc[2][2][4][2];
#pragma unroll
    for (int a = 0; a < 2; ++a)
#pragma unroll
        for (int b = 0; b < 2; ++b)
#pragma unroll
            for (int m = 0; m < 4; ++m)
#pragma unroll
                for (int n = 0; n < 2; ++n) acc[a][b][m][n] = (f32x4){0.f, 0.f, 0.f, 0.f};
    bf16x8 At[4][2], B0[2][2], B1[2][2];
    const char* cA = (const char*)Ap + cur.aoff; const char* cB = (const char*)Btp + cur.boff;
    G_STAGE(G_SB(0, 0), cB, voffB); G_STAGE(G_SA(0, 0), cA, voffA); G_STAGE(G_SB(0, 1), cB + hB, voffB); G_STAGE(G_SA(0, 1), cA + hA, voffA);
    if (wr == 1) G_BAR;
    G_WAIT_V(4); G_BAR;
    G_STAGE(G_SB(1, 0), cB + kstep, voffB); G_STAGE(G_SA(1, 0), cA + kstep, voffA); G_STAGE(G_SB(1, 1), cB + hB + kstep, voffB);
    G_WAIT_V(6); G_BAR;
    for (;;) {
        const bool has_next = S.next(ui + 1, nxt);
        const char* nA = has_next ? (const char*)Ap + nxt.aoff : cA; const char* nB = has_next ? (const char*)Btp + nxt.boff : cB;
        for (int t = 0; t < nt; t += 2) {
            const bool last = (t == nt - 2);
            const char* a1 = cA + (size_t)(t + 1) * kstep;
            const char* a2 = last ? nA : cA + (size_t)(t + 2) * kstep; const char* b2 = last ? nB : cB + (size_t)(t + 2) * kstep;
            const char* a3 = a2 + kstep; const char* b3 = b2 + kstep;
            G_LDB(B0, 0, 0); G_SCHED; G_LDA(At, 0, 0); G_STAGE(G_SA(1, 1), a1 + hA, voffA);
            G_WAIT_L(8); G_BAR; G_WAIT_L(0); G_MMA(0, 0, At, B0); G_BAR; G_SCHED;
            G_LDB(B1, 0, 1); G_STAGE(G_SB(0, 0), b2, voffB);
            G_BAR; G_WAIT_L(0); G_MMA(0, 1, At, B1); G_BAR;
            G_LDA(At, 0, 1); G_STAGE(G_SA(0, 0), a2, voffA);
            G_BAR; G_WAIT_L(0); G_MMA(1, 0, At, B0); G_BAR; G_SCHED;
            G_STAGE(G_SB(0, 1), b2 + hB, voffB);
            G_WAIT_V(6); G_BAR; G_MMA(1, 1, At, B1); G_BAR;
            G_LDB(B0, 1, 0); G_SCHED; G_LDA(At, 1, 0); G_STAGE(G_SA(0, 1), a2 + hA, voffA);
            G_WAIT_L(8); G_BAR; G_WAIT_L(0); G_MMA(0, 0, At, B0); G_BAR; G_SCHED;
            G_LDB(B1, 1, 1); G_STAGE(G_SB(1, 0), b3, voffB);
            G_BAR; G_WAIT_L(0); G_MMA(0, 1, At, B1); G_BAR;
            G_LDA(At, 1, 1); G_STAGE(G_SA(1, 0), a3, voffA);
            G_BAR; G_WAIT_L(0); G_MMA(1, 0, At, B0); G_BAR; G_SCHED;
            G_STAGE(G_SB(1, 1), b3 + hB, voffB);
            G_WAIT_V(6); G_BAR; G_MMA(1, 1, At, B1); G_BAR;
        }
        E(acc, cur, wr, wc, fr, fq);
        if (!has_next) break;
#pragma unroll
        for (int a = 0; a < 2; ++a)
#pragma unroll
            for (int b = 0; b < 2; ++b)
#pragma unroll
                for (int m = 0; m < 4; ++m)
#pragma unroll
                    for (int n = 0; n < 2; ++n) acc[a][b][m][n] = (f32x4){0.f, 0.f, 0.f, 0.f};
        cur = nxt; cA = nA; cB = nB; ++ui;
    }
    G_WAIT_V(0);
    if (wr == 0) G_BAR;
    G_BAR;
#undef G_SA
#undef G_SB
#undef G_STAGE
#undef G_LDA
#undef G_LDB
#undef G_MMA
#undef G_WAIT_V
#undef G_WAIT_L
#undef G_BAR
#undef G_SCHED
}

__device__ void prep_phase(const Args& a, LAS unsigned char* lds) {
    LAS float* tile = (LAS float*)lds;
    const int tid0 = tid_opaque(); const int tx = tid0 & 63, ty = tid0 >> 6;
    constexpr int T0 = 768, T1 = T0 + 128, T2 = T1 + 192, T3 = T2 + 256, T4 = T3 + 1408, T5 = T4 + 704, T6 = T5 + 512, T7 = T6 + 256, T8 = T7 + 1408, T9 = T8 + 704;
    for (int t = blockIdx.x; t < T9; t += gridDim.x) {
        int mat, lt, kt; size_t doff; int Kd;
        if (t < T0) { mat = 0; lt = t; kt = 16; doff = O_WRKV; Kd = 1024; }
        else if (t < T1) { mat = 1; lt = t - T0; kt = 16; doff = O_WL1; Kd = 1024; }
        else if (t < T2) { mat = 2; lt = t - T1; kt = 4; doff = O_L2T; Kd = 256; }
        else if (t < T3) { mat = 3; lt = t - T2; kt = 16; doff = O_WOT; Kd = 1024; }
        else if (t < T4) { mat = 4; lt = t - T3; kt = 16; doff = O_F1T1; Kd = 1024; }
        else if (t < T5) { mat = 5; lt = t - T4; kt = 44; doff = O_F2T1; Kd = FH; }
        else if (t < T6) { mat = 6; lt = t - T5; kt = 16; doff = O_W1T; Kd = 1024; }
        else if (t < T7) { mat = 7; lt = t - T6; kt = 16; doff = O_W2T; Kd = 1024; }
        else if (t < T8) { mat = 8; lt = t - T7; kt = 16; doff = O_F1T0; Kd = 1024; }
        else { mat = 9; lt = t - T8; kt = 44; doff = O_F2T0; Kd = FH; }
        const int n0 = (lt / kt) * 64, k0 = (lt % kt) * 64;
        const float* base = nullptr; int ld = 1024, mode = 0; const float* mup = a.in[13];
        if (mat == 0) { base = a.in[14] + ((size_t)(n0 >> 10) * 1024 + k0) * 1024 + (n0 & 1023); }
        else if (mat == 1) { const int nn = n0 & 255; int mi;
            if (nn < 64) { base = a.in[16] + (size_t)k0 * 64; ld = 64; mi = 1; } else if (nn < 128) { base = a.in[19] + (size_t)k0 * 64; ld = 64; mi = 4; } else { base = a.in[21] + (size_t)k0 * 128 + (nn - 128); ld = 128; mi = 5; }
            mode = (n0 >= 256) ? 1 : 2; mup = a.in[13] + mi * 1024 + k0; }
        else if (mat == 2) {
            if (n0 < 1024) { if (k0 == 0) base = a.in[17] + n0; else mode = 3; }
            else if (n0 < 2048) { if (k0 == 64) base = a.in[20] + (n0 - 1024); else mode = 3; }
            else { if (k0 >= 128) base = a.in[22] + (size_t)(k0 - 128) * 1024 + (n0 - 2048); else mode = 3; } }
        else if (mat == 3) { base = a.in[28] + (size_t)k0 * 1024 + n0; }
        else if (mat == 4 || mat == 8) { const int pn = n0 >> 8, r = n0 & 255; const int col0 = (r < 128) ? 128 * pn + r : FH + 128 * pn + r - 128; ld = 2 * FH;
            base = a.in[29] + (size_t)(mat == 4 ? 1 : 0) * 1024 * 2 * FH + (size_t)k0 * 2 * FH + col0; }
        else if (mat == 5 || mat == 9) { base = a.in[30] + (size_t)(mat == 5 ? 1 : 0) * FH * 1024 + (size_t)k0 * 1024 + n0; }
        else if (mat == 6) { const int pn = n0 >> 8, r = n0 & 255; const int col0 = (pn < 4) ? ((r < 128) ? 128 * pn + r : 512 + 128 * pn + r - 128) : n0; ld = 2048; base = a.in[1] + (size_t)k0 * 2048 + col0; }
        else { base = a.in[11] + (size_t)k0 * 1024 + n0; }
        if (mode == 3) {
#pragma unroll
            for (int i = 0; i < 8; ++i) tile[(ty + 8 * i) * 65 + tx] = 0.f;
        } else {
            float v[8];
#pragma unroll
            for (int i = 0; i < 8; ++i) v[i] = base[(size_t)(ty + 8 * i) * ld + tx];
            if (mode == 1) {
#pragma unroll
                for (int i = 0; i < 8; ++i) v[i] *= mup[ty + 8 * i];
            } else if (mode == 2) {
#pragma unroll
                for (int i = 0; i < 8; ++i) v[i] *= (1.0f - mup[ty + 8 * i]);
            }
#pragma unroll
            for (int i = 0; i < 8; ++i) tile[(ty + 8 * i) * 65 + tx] = v[i];
        }
        __syncthreads();
        bf16_t* dst = (bf16_t*)(a.ws + doff);
        const int kq = tid0 & 15, nr = tid0 >> 4;
#pragma unroll
        for (int i = 0; i < 2; ++i) { const int n = nr + 32 * i;
            f32x4 w; w[0] = tile[(4 * kq + 0) * 65 + n]; w[1] = tile[(4 * kq + 1) * 65 + n]; w[2] = tile[(4 * kq + 2) * 65 + n]; w[3] = tile[(4 * kq + 3) * 65 + n];
            *(u32x2*)(dst + (size_t)(n0 + n) * Kd + k0 + 4 * kq) = pack4(w); }
        __syncthreads();
    }
    const float* x = a.in[0]; bf16_t* xb = (bf16_t*)(a.ws + SLOTP(0));
    for (size_t i = (size_t)blockIdx.x * 512 + tid0; i < (size_t)MT * DM / 4; i += (size_t)gridDim.x * 512) {
        const f32x4 v = *(const f32x4*)(x + 4 * i); *(u32x2*)(xb + 4 * i) = pack4(v);
    }
}

__device__ void conv_tile(const Args& a, LAS unsigned char* lds, int tile) {
    LAS bf16_t* in = (LAS bf16_t*)lds;
    LAS float* outf = (LAS float*)(lds + 63488);
    const bf16_t* ypre = (const bf16_t*)(a.ws + SLOTP(1));
    bf16_t* mixed = (bf16_t*)(a.ws + SLOTP(3));
    const int tid = tid_opaque(), wid = tid >> 6, lane = tid & 63;
    const int m0 = tile * 32, s0 = m0 & (SEQL - 1);
    for (int v = tid; v < 62 * 64; v += 512) {
        const int r = v >> 6, cv = v & 63; u32x4 val = (u32x4){0u, 0u, 0u, 0u};
        if (s0 - 30 + r >= 0) val = *(const u32x4*)(ypre + (size_t)(m0 - 30 + r) * 512 + cv * 8);
        *(LAS u32x4*)(in + r * 512 + cv * 8) = val;
    }
    __syncthreads();
    {
        const int c = tid; const float* cwp = a.in[3]; float cw[31];
#pragma unroll
        for (int w = 0; w < 31; ++w) cw[w] = cwp[w * 512 + c];
        const float cb = a.in[4][c];
        float xin[62];
#pragma unroll
        for (int r = 0; r < 62; ++r) xin[r] = bf2f(in[r * 512 + c]);
#pragma unroll
        for (int tt = 0; tt < 32; ++tt) { float s = cb;
#pragma unroll
            for (int w = 0; w < 31; ++w) s += xin[tt + w] * cw[w];
            outf[tt * 512 + c] = s; }
    }
    __syncthreads();
    {
        const float* g = a.in[5]; const float* b = a.in[6];
        const f32x4 g0 = *(const f32x4*)(g + 4 * lane), g1 = *(const f32x4*)(g + 256 + 4 * lane), b0 = *(const f32x4*)(b + 4 * lane), b1 = *(const f32x4*)(b + 256 + 4 * lane);
        for (int tt = wid; tt < 32; tt += 8) {
            f32x4 v0 = *(const LAS f32x4*)(outf + tt * 512 + 4 * lane), v1 = *(const LAS f32x4*)(outf + tt * 512 + 256 + 4 * lane);
            float s = (v0[0] + v0[1]) + (v0[2] + v0[3]) + (v1[0] + v1[1]) + (v1[2] + v1[3]);
            const float mean = wave_sum(s) * (1.0f / 512.0f);
            v0 -= mean; v1 -= mean;
            float q = v0[0] * v0[0] + v0[1] * v0[1] + v0[2] * v0[2] + v0[3] * v0[3] + v1[0] * v1[0] + v1[1] * v1[1] + v1[2] * v1[2] + v1[3] * v1[3];
            const float rstd = rsqrtf(wave_sum(q) * (1.0f / 512.0f) + 1e-5f);
            v0 = v0 * rstd * g0 + b0; v1 = v1 * rstd * g1 + b1;
#pragma unroll
            for (int j = 0; j < 4; ++j) { v0[j] = v0[j] * sigmoidf_(v0[j]); v1[j] = v1[j] * sigmoidf_(v1[j]); }
            bf16_t* o = mixed + (size_t)(m0 + tt) * DM;
            *(u32x2*)(o + 4 * lane) = pack4(v0); *(u32x2*)(o + 256 + 4 * lane) = pack4(v1);
        }
    }
    __syncthreads();
}
__device__ void sgu_item(const Args& a, LAS unsigned char* lds, int item) {
    LAS bf16_t* Wl = (LAS bf16_t*)lds;
    LAS bf16_t* VT = (LAS bf16_t*)(lds + 34816);
    LAS float* st = (LAS float*)(lds + 69632);
    const bf16_t* ug = (const bf16_t*)(a.ws + SLOTP(1) + 16 * MiB);
    const bf16_t* vg = (const bf16_t*)(a.ws + SLOTP(2));
    bf16_t* mixed = (bf16_t*)(a.ws + SLOTP(3));
    const int tid = tid_opaque(), wid = tid >> 6, lane = tid & 63;
    const int g = item & 3, m0 = (item >> 2) * 128;
    for (int i = 0; i < 16; ++i) {
        const int tok = 16 * wid + i; float f[8]; unpack8(*(const u32x4*)(vg + (size_t)(m0 + tok) * 512 + lane * 8), f);
        float s = 0.f;
#pragma unroll
        for (int e = 0; e < 8; ++e) s += f[e];
        const float mean = wave_sum(s) * (1.0f / 512.0f); float q = 0.f;
#pragma unroll
        for (int e = 0; e < 8; ++e) { const float d = f[e] - mean; q += d * d; }
        const float rstd = rsqrtf(wave_sum(q) * (1.0f / 512.0f) + 1e-5f);
        if (lane == 0) { st[2 * tok] = mean; st[2 * tok + 1] = rstd; }
    }
    __syncthreads();
    {
        const int s = tid & 127, dq = tid >> 7; const float mean = st[2 * s], rstd = st[2 * s + 1];
        const float* sg = a.in[7] + g * 128; const float* sb = a.in[8] + g * 128;
#pragma unroll
        for (int i = 0; i < 4; ++i) {
            const int d0 = (dq * 4 + i) * 8; float f[8]; unpack8(*(const u32x4*)(vg + (size_t)(m0 + s) * 512 + g * 128 + d0), f);
#pragma unroll
            for (int e = 0; e < 8; ++e) VT[(d0 + e) * 136 + s] = f2bf((f[e] - mean) * rstd * sg[d0 + e] + sb[d0 + e]);
        }
        const float* W = a.in[9] + (size_t)g * 128 * 128;
        for (int idx = tid; idx < 128 * 32; idx += 512) {
            const int t = idx >> 5, s4 = (idx & 31) * 4; f32x4 w = *(const f32x4*)(W + t * 128 + s4);
#pragma unroll
            for (int e = 0; e < 4; ++e) if (s4 + e > t) w[e] = 0.f;
            *(LAS u32x2*)(Wl + t * 136 + s4) = pack4(w);
        }
    }
    __syncthreads();
    {
        const int t0 = 16 * wid, row = lane & 15, quad = lane >> 4;
        f32x4 acc[8];
#pragma unroll
        for (int db = 0; db < 8; ++db) acc[db] = (f32x4){0.f, 0.f, 0.f, 0.f};
        for (int s0 = 0; s0 < t0 + 16; s0 += 32) {
            const bf16x8 av = *(const LAS bf16x8*)(Wl + (t0 + row) * 136 + s0 + quad * 8);
#pragma unroll
            for (int db = 0; db < 8; ++db) { const bf16x8 bv = *(const LAS bf16x8*)(VT + (db * 16 + row) * 136 + s0 + quad * 8);
                acc[db] = __builtin_amdgcn_mfma_f32_16x16x32_bf16(av, bv, acc[db], 0, 0, 0); }
        }
        const float* sbias = a.in[10] + g * 128;
#pragma unroll
        for (int db = 0; db < 8; ++db)
#pragma unroll
            for (int j = 0; j < 4; ++j) {
                const int t = t0 + quad * 4 + j, d = db * 16 + row; const float sv = acc[db][j] + sbias[t];
                const float uv = bf2f(ug[(size_t)(m0 + t) * 512 + g * 128 + d]);
                mixed[(size_t)(m0 + t) * DM + 512 + g * 128 + d] = f2bf(uv * sv);
            }
    }
    __syncthreads();
}

struct Row16 { f32x4 v[4]; };
__device__ __forceinline__ void row_load(const float* p, int lane, Row16& r) {
#pragma unroll
    for (int i = 0; i < 4; ++i) r.v[i] = *(const f32x4*)(p + 256 * i + 4 * lane);
}
__device__ __forceinline__ void row_ln(Row16& r, const Row16& g, const Row16& b) {
    float s = 0.f;
#pragma unroll
    for (int i = 0; i < 4; ++i) s += (r.v[i][0] + r.v[i][1]) + (r.v[i][2] + r.v[i][3]);
    const float mean = wave_sum(s) * (1.0f / 1024.0f); float q = 0.f;
#pragma unroll
    for (int i = 0; i < 4; ++i) { r.v[i] -= mean; q += r.v[i][0] * r.v[i][0] + r.v[i][1] * r.v[i][1] + r.v[i][2] * r.v[i][2] + r.v[i][3] * r.v[i][3]; }
    const float rstd = rsqrtf(wave_sum(q) * (1.0f / 1024.0f) + 1e-5f);
#pragma unroll
    for (int i = 0; i < 4; ++i) r.v[i] = r.v[i] * rstd * g.v[i] + b.v[i];
}
__device__ __forceinline__ void row_store_bf(bf16_t* p, int lane, const Row16& r) {
#pragma unroll
    for (int i = 0; i < 4; ++i) *(u32x2*)(p + 256 * i + 4 * lane) = pack4(r.v[i]);
}
__device__ void ln_phase(const float* src, float* dstf, bf16_t* dstb, const float* gp, const float* bp) {
    const int tid = tid_opaque(); const int lane = tid & 63, gw = blockIdx.x * 8 + (tid >> 6), nw = gridDim.x * 8;
    Row16 g, b; row_load(gp, lane, g); row_load(bp, lane, b);
    for (int row = gw; row < MT; row += nw) {
        Row16 r; row_load(src + (size_t)row * DM, lane, r); row_ln(r, g, b);
#pragma unroll
        for (int i = 0; i < 4; ++i) *(f32x4*)(dstf + (size_t)row * DM + 256 * i + 4 * lane) = r.v[i];
        if (dstb) row_store_bf(dstb + (size_t)row * DM, lane, r);
    }
}
__device__ void ln_shift_phase(const Args& a) {
    const float* src = (const float*)(a.ws + SLOTP(4)); float* xf = a.out;
    bf16_t* xr = (bf16_t*)(a.ws + SLOTP(0)); bf16_t* xk = (bf16_t*)(a.ws + SLOTP(1)); bf16_t* xv = (bf16_t*)(a.ws + SLOTP(2)); bf16_t* xg = (bf16_t*)(a.ws + SLOTP(3));
    const int tid = tid_opaque(); const int lane = tid & 63, gw = blockIdx.x * 8 + (tid >> 6), nw = gridDim.x * 8;
    Row16 g, b, mr, mk, mv; row_load(a.in[33], lane, g); row_load(a.in[34], lane, b);
    row_load(a.in[13], lane, mr); row_load(a.in[13] + 2 * 1024, lane, mk); row_load(a.in[13] + 3 * 1024, lane, mv);
    for (int ch = gw; ch < MT / 8; ch += nw) {
        const int r0 = ch * 8; Row16 prev;
        if ((r0 & (SEQL - 1)) == 0) {
#pragma unroll
            for (int i = 0; i < 4; ++i) prev.v[i] = (f32x4){0.f, 0.f, 0.f, 0.f};
        } else { row_load(src + (size_t)(r0 - 1) * DM, lane, prev); row_ln(prev, g, b); }
        for (int r = r0; r < r0 + 8; ++r) {
            Row16 cur; row_load(src + (size_t)r * DM, lane, cur); row_ln(cur, g, b);
#pragma unroll
            for (int i = 0; i < 4; ++i) *(f32x4*)(xf + (size_t)r * DM + 256 * i + 4 * lane) = cur.v[i];
            row_store_bf(xg + (size_t)r * DM, lane, cur);
            Row16 t;
#pragma unroll
            for (int i = 0; i < 4; ++i) t.v[i] = cur.v[i] + (prev.v[i] - cur.v[i]) * mr.v[i];
            row_store_bf(xr + (size_t)r * DM, lane, t);
#pragma unroll
            for (int i = 0; i < 4; ++i) t.v[i] = cur.v[i] + (prev.v[i] - cur.v[i]) * mk.v[i];
            row_store_bf(xk + (size_t)r * DM, lane, t);
#pragma unroll
            for (int i = 0; i < 4; ++i) t.v[i] = cur.v[i] + (prev.v[i] - cur.v[i]) * mv.v[i];
            row_store_bf(xv + (size_t)r * DM, lane, t);
            prev = cur;
        }
    }
}

__device__ void hid_phase(const Args& a) {
    const bf16_t* pq = (const bf16_t*)(a.ws + O_W1T); bf16_t* hid = (bf16_t*)(a.ws + O_HID);
    const int t0 = tid_opaque();
    for (int idx = blockIdx.x * 512 + t0; idx < MT * 64; idx += gridDim.x * 512) {
        const int m = idx >> 6, c4 = (idx & 63) * 4;
        const u32x2 q = *(const u32x2*)(pq + (size_t)m * 512 + c4);
        u32x2 p = (u32x2){0u, 0u}; if (m & (SEQL - 1)) p = *(const u32x2*)(pq + (size_t)(m - 1) * 512 + 256 + c4);
        f32x4 v; v[0] = __uint_as_float(q.x << 16) + __uint_as_float(p.x << 16); v[1] = __uint_as_float(q.x & 0xffff0000u) + __uint_as_float(p.x & 0xffff0000u);
        v[2] = __uint_as_float(q.y << 16) + __uint_as_float(p.y << 16); v[3] = __uint_as_float(q.y & 0xffff0000u) + __uint_as_float(p.y & 0xffff0000u);
        if (c4 < 64) {
#pragma unroll
            for (int j = 0; j < 4; ++j) v[j] = 2.0f * sigmoidf_(2.0f * v[j]) - 1.0f;
        } else if (c4 >= 128) {
#pragma unroll
            for (int j = 0; j < 4; ++j) v[j] = sigmoidf_(v[j]);
        }
        *(u32x2*)(hid + (size_t)m * 256 + c4) = pack4(v);
    }
}

constexpr int TC = 32, SBUF = (5 * TC * 64 + TC * 16) * 4;
#define SCAN_BAR() do { asm volatile("s_waitcnt lgkmcnt(0)" ::: "memory"); __builtin_amdgcn_s_barrier(); asm volatile("" ::: "memory"); } while (0)
__device__ void scan_phase(const Args& a, LAS unsigned char* lds) {
    const bf16_t* rp = (const bf16_t*)(a.ws + SLOTP(4)); const bf16_t* kp = (const bf16_t*)(a.ws + SLOTP(5)); const bf16_t* vp = (const bf16_t*)(a.ws + SLOTP(0));
    const bf16_t* ep = (const bf16_t*)(a.ws + SLOTP(1)); const bf16_t* ap = (const bf16_t*)(a.ws + SLOTP(2));
    bf16_t* yraw = (bf16_t*)(a.ws + SLOTP(3)); float* ct = (float*)(a.ws + O_CT);
    const int tid = tid_opaque(), wid = tid >> 6, lane = tid & 63;
    for (int item = blockIdx.x; item < 256; item += gridDim.x) {
        const int xcd = item & 7, slot = item >> 3, hg = xcd * 8 + (slot >> 2), q = slot & 3, bb = hg >> 4, h = hg & 15;
        const size_t mbase = (size_t)bb * SEQL;
        const int col = h * 64 + lane;
        const float kkc = a.in[23][col], kac = a.in[24][col], rkc = a.in[25][col], omk = 1.0f - kac;
        unsigned short rr[8], kk[8], vv[8], ee[8], aa[8];
        const int sw = wid - 4;
        auto stage_load = [&](int c) {
#pragma unroll
            for (int i = 0; i < 8; ++i) { const size_t idx = (mbase + c * TC + sw * 8 + i) * DM + col;
                rr[i] = rp[idx]; kk[i] = kp[idx]; vv[i] = vp[idx]; ee[i] = ep[idx]; aa[i] = ap[idx]; }
        };
        auto stage_proc = [&](int c, int bufi) {
            LAS float* B = (LAS float*)(lds + bufi * SBUF);
#pragma unroll
            for (int i = 0; i < 8; ++i) {
                const int tl = sw * 8 + i;
                const float kf = bf2f(kk[i]), af = bf2f(aa[i]), rf = bf2f(rr[i]);
                const float kkr = kf * kkc; const float ss = wave_sum(kkr * kkr); const float inv = __builtin_amdgcn_rsqf(fmaxf(ss, 1e-24f));
                const float nkk = -kkr * inv; const float kpr = kf * (af * kac + omk);
                B[0 * TC * 64 + tl * 64 + lane] = __expf(-bf2f(ee[i]));
                B[1 * TC * 64 + tl * 64 + lane] = nkk;
                B[2 * TC * 64 + tl * 64 + lane] = -nkk * af;
                B[3 * TC * 64 + tl * 64 + lane] = kpr;
                B[4 * TC * 64 + tl * 64 + lane] = rf;
                if ((lane >> 4) == q) B[5 * TC * 64 + tl * 16 + (lane & 15)] = bf2f(vv[i]);
                if (q == 0) { const float cterm = wave_sum(rf * kpr * rkc); if (lane == 0) ct[(mbase + c * TC + tl) * 16 + h] = cterm; }
            }
        };
        if (wid >= 4) { stage_load(0); stage_proc(0, 0); stage_load(1); }
        SCAN_BAR();
        f32x2 S0 = (f32x2){0.f, 0.f}, S1 = (f32x2){0.f, 0.f};
        const int il = lane >> 4, jl = lane & 15, rowl = 4 * (wid & 3) + il;
        for (int c = 0; c < SEQL / TC; ++c) {
            if (wid >= 4) { if (c + 1 < SEQL / TC) { stage_proc(c + 1, (c + 1) & 1); if (c + 2 < SEQL / TC) stage_load(c + 2); } }
            else {
                const LAS float* B = (const LAS float*)(lds + (c & 1) * SBUF);
                bf16_t* yo = yraw + (mbase + c * TC + jl) * DM + h * 64 + 16 * q + rowl;
#pragma unroll
                for (int t16 = 0; t16 < TC; t16 += 16) {
                    float ykeep = 0.f;
#pragma unroll
                    for (int ts = 0; ts < 16; ++ts) {
                        const int tl = t16 + ts;
                        const f32x4 w4 = *(const LAS f32x4*)(B + 0 * TC * 64 + tl * 64 + 4 * jl), n4 = *(const LAS f32x4*)(B + 1 * TC * 64 + tl * 64 + 4 * jl),
                                    b4 = *(const LAS f32x4*)(B + 2 * TC * 64 + tl * 64 + 4 * jl), k4 = *(const LAS f32x4*)(B + 3 * TC * 64 + tl * 64 + 4 * jl),
                                    r4 = *(const LAS f32x4*)(B + 4 * TC * 64 + tl * 64 + 4 * jl);
                        const float vi = B[5 * TC * 64 + tl * 16 + rowl];
                        const f32x2 vi2 = (f32x2){vi, vi};
                        const f32x2 p = S0 * (f32x2){n4[0], n4[1]} + S1 * (f32x2){n4[2], n4[3]};
                        const float sa = red16(p[0] + p[1]);
                        const f32x2 sa2 = (f32x2){sa, sa};
                        S0 = S0 * (f32x2){w4[0], w4[1]} + (f32x2){k4[0], k4[1]} * vi2;
                        S1 = S1 * (f32x2){w4[2], w4[3]} + (f32x2){k4[2], k4[3]} * vi2;
                        S0 = (f32x2){b4[0], b4[1]} * sa2 + S0;
                        S1 = (f32x2){b4[2], b4[3]} * sa2 + S1;
                        const f32x2 yy = S0 * (f32x2){r4[0], r4[1]} + S1 * (f32x2){r4[2], r4[3]};
                        const float y = red16(yy[0] + yy[1]);
                        ykeep = (jl == ts) ? y : ykeep;
                    }
                    yo[(size_t)t16 * DM] = f2bf(ykeep);
                }
            }
            SCAN_BAR();
        }
        __syncthreads();
    }
}
__device__ void post_phase(const Args& a) {
    const bf16_t* yraw = (const bf16_t*)(a.ws + SLOTP(3)); const bf16_t* vp = (const bf16_t*)(a.ws + SLOTP(0)); const bf16_t* gg = (const bf16_t*)(a.ws + SLOTP(4));
    const float* ct = (const float*)(a.ws + O_CT); bf16_t* yb = (bf16_t*)(a.ws + SLOTP(5));
    const int tid = tid_opaque(); const int lane = tid & 63, gw = blockIdx.x * 8 + (tid >> 6), nw = gridDim.x * 8;
    const int c0 = 16 * lane;
    float lg[16], lb[16];
#pragma unroll
    for (int i = 0; i < 16; ++i) { lg[i] = a.in[26][c0 + i]; lb[i] = a.in[27][c0 + i]; }
    for (int row = gw; row < MT; row += nw) {
        const size_t o = (size_t)row * DM + c0; float y[16], v[16], g[16];
        unpack8(*(const u32x4*)(yraw + o), *(float(*)[8])&y[0]); unpack8(*(const u32x4*)(yraw + o + 8), *(float(*)[8])&y[8]);
        unpack8(*(const u32x4*)(vp + o), *(float(*)[8])&v[0]); unpack8(*(const u32x4*)(vp + o + 8), *(float(*)[8])&v[8]);
        unpack8(*(const u32x4*)(gg + o), *(float(*)[8])&g[0]); unpack8(*(const u32x4*)(gg + o + 8), *(float(*)[8])&g[8]);
        const float cv = ct[(size_t)row * 16 + (lane >> 2)];
        float s = 0.f;
#pragma unroll
        for (int i = 0; i < 16; ++i) s += y[i];
        s += dpp_mov<0xB1>(s); s += dpp_mov<0x4E>(s);
        const float mean = s * (1.0f / 64.0f); float qq = 0.f;
#pragma unroll
        for (int i = 0; i < 16; ++i) { y[i] -= mean; qq += y[i] * y[i]; }
        qq += dpp_mov<0xB1>(qq); qq += dpp_mov<0x4E>(qq);
        const float rstd = rsqrtf(qq * (1.0f / 64.0f) + 64e-5f);
        u32x4 w0, w1; float of[16];
#pragma unroll
        for (int i = 0; i < 16; ++i) of[i] = (y[i] * rstd * lg[i] + lb[i] + cv * v[i]) * g[i];
#pragma unroll
        for (int i = 0; i < 4; ++i) { w0[i] = cvt_pk_bf16(of[2 * i], of[2 * i + 1]); w1[i] = cvt_pk_bf16(of[8 + 2 * i], of[8 + 2 * i + 1]); }
        *(u32x4*)(yb + o) = w0; *(u32x4*)(yb + o + 8) = w1;
    }
}

__device__ __forceinline__ void grid_barrier(unsigned* cnt, unsigned& epoch) {
    __syncthreads();
    epoch += gridDim.x;
    if (threadIdx.x == 0) {
        __builtin_amdgcn_fence(__ATOMIC_RELEASE, "agent");
        __hip_atomic_fetch_add(cnt, 1u, __ATOMIC_RELAXED, __HIP_MEMORY_SCOPE_AGENT);
        while (__hip_atomic_load(cnt, __ATOMIC_RELAXED, __HIP_MEMORY_SCOPE_AGENT) < epoch) __builtin_amdgcn_s_sleep(1);
        __builtin_amdgcn_fence(__ATOMIC_ACQUIRE, "agent");
    }
    __syncthreads();
}
constexpr int NPHASE = 19;
__global__ void __launch_bounds__(512, 2) mk_fwd(Args a) {
    extern __shared__ __attribute__((aligned(16))) unsigned char smem[];
    LAS unsigned char* lds = (LAS unsigned char*)smem;
    cg::grid_group grid = cg::this_grid();
    unsigned char* ws = a.ws;
    unsigned epoch = 0; unsigned* barcnt = (unsigned*)(ws + O_BAR);
    if (a.ph_hi < 0) grid.sync();
#define GSYNC() grid_barrier(barcnt, epoch)
#define BFP(off) ((bf16_t*)(ws + (off)))
    if (a.ph_lo <= 0 && 0 < a.ph_hi) { if (ONLY < 0 || ONLY == 0) { for (int rep_ = 0; rep_ < (DUP == 0 ? 2 : 1); ++rep_) { if (rep_) GSYNC(); prep_phase(a, lds); } }
        if (0 + 1 < a.ph_hi) GSYNC(); }
    if (a.ph_lo <= 1 && 1 < a.ph_hi) { if (ONLY < 0 || ONLY == 1) { for (int rep_ = 0; rep_ < (DUP == 1 ? 2 : 1); ++rep_) { if (rep_) GSYNC(); { StaticOrder S{64, 8, 2048, 2048}; EpiG1 E{BFP(SLOTP(1)), BFP(SLOTP(1) + 16 * MiB), BFP(SLOTP(2)), a.in[2]};
            gemm_phase(lds, BFP(SLOTP(0)), BFP(O_W1T), 1024, 2048, S, E); } } }
        if (1 + 1 < a.ph_hi) GSYNC(); }
    if (a.ph_lo <= 2 && 2 < a.ph_hi) { if (ONLY < 0 || ONLY == 2) { for (int rep_ = 0; rep_ < (DUP == 2 ? 2 : 1); ++rep_) { if (rep_) GSYNC(); { for (int t = blockIdx.x; t < 512; t += gridDim.x) conv_tile(a, lds, t);
            for (int t = blockIdx.x; t < 512; t += gridDim.x) sgu_item(a, lds, t); } } }
        if (2 + 1 < a.ph_hi) GSYNC(); }
    if (a.ph_lo <= 3 && 3 < a.ph_hi) { if (ONLY < 0 || ONLY == 3) { for (int rep_ = 0; rep_ < (DUP == 3 ? 2 : 1); ++rep_) { if (rep_) GSYNC(); { StaticOrder S{64, 4, 2048, 2048}; EpiRes E{a.in[0], a.out, a.in[12]}; gemm_phase(lds, BFP(SLOTP(3)), BFP(O_W2T), 1024, 2048, S, E); } } }
        if (3 + 1 < a.ph_hi) GSYNC(); }
    if (a.ph_lo <= 4 && 4 < a.ph_hi) { if (ONLY < 0 || ONLY == 4) { for (int rep_ = 0; rep_ < (DUP == 4 ? 2 : 1); ++rep_) { if (rep_) GSYNC(); ln_phase(a.out, a.out, BFP(SLOTP(0)), a.in[31], a.in[32]); } }
        if (4 + 1 < a.ph_hi) GSYNC(); }
    if (a.ph_lo <= 5 && 5 < a.ph_hi) { if (ONLY < 0 || ONLY == 5) { for (int rep_ = 0; rep_ < (DUP == 5 ? 2 : 1); ++rep_) { if (rep_) GSYNC(); { StaticOrder S{64, 22, 2048, 2048}; EpiSwiglu E{BFP(SLOTP(1))}; gemm_phase(lds, BFP(SLOTP(0)), BFP(O_F1T0), 1024, 2048, S, E); } } }
        if (5 + 1 < a.ph_hi) GSYNC(); }
    if (a.ph_lo <= 6 && 6 < a.ph_hi) { if (ONLY < 0 || ONLY == 6) { for (int rep_ = 0; rep_ < (DUP == 6 ? 2 : 1); ++rep_) { if (rep_) GSYNC(); { StaticOrder S{64, 4, 2 * FH, 2 * FH}; EpiRes E{a.out, (float*)(ws + SLOTP(4)), nullptr}; gemm_phase(lds, BFP(SLOTP(1)), BFP(O_F2T0), FH, 2 * FH, S, E); } } }
        if (6 + 1 < a.ph_hi) GSYNC(); }
    if (a.ph_lo <= 7 && 7 < a.ph_hi) { if (ONLY < 0 || ONLY == 7) { for (int rep_ = 0; rep_ < (DUP == 7 ? 2 : 1); ++rep_) { if (rep_) GSYNC(); ln_shift_phase(a); } }
        if (7 + 1 < a.ph_hi) GSYNC(); }
    if (a.ph_lo <= 8 && 8 < a.ph_hi) { if (ONLY < 0 || ONLY == 8) { for (int rep_ = 0; rep_ < (DUP == 8 ? 2 : 1); ++rep_) { if (rep_) GSYNC(); { StaticOrder S2{64, 2, 2048, 2048}; EpiBf<3> E2{BFP(O_W1T), nullptr, 0, nullptr, nullptr}; gemm_phase(lds, BFP(SLOTP(3)), BFP(O_WL1), 1024, 2048, S2, E2);
            GroupOrder S{2, SLOT}; EpiBf<0> E{BFP(SLOTP(4)), nullptr, SLOT / 2, nullptr, nullptr}; gemm_phase(lds, BFP(SLOTP(0)), BFP(O_WRKV), 1024, 2048, S, E); } } }
        if (8 + 1 < a.ph_hi) GSYNC(); }
    if (a.ph_lo <= 9 && 9 < a.ph_hi) { if (ONLY < 0 || ONLY == 9) { for (int rep_ = 0; rep_ < (DUP == 9 ? 2 : 1); ++rep_) { if (rep_) GSYNC(); { StaticOrder S{64, 4, 2048, 2048}; EpiBf<0> E{BFP(SLOTP(0)), nullptr, 0, nullptr, nullptr}; gemm_phase(lds, BFP(SLOTP(2)), BFP(O_WRKV + 4 * MiB), 1024, 2048, S, E); hid_phase(a); } } }
        if (9 + 1 < a.ph_hi) GSYNC(); }
    if (a.ph_lo <= 10 && 10 < a.ph_hi) { if (ONLY < 0 || ONLY == 10) { for (int rep_ = 0; rep_ < (DUP == 10 ? 2 : 1); ++rep_) { if (rep_) GSYNC(); { StaticOrder S{64, 4, 512, 512}; EpiBf<2> E{BFP(SLOTP(1)), nullptr, 0, a.in[15], nullptr}; gemm_phase(lds, BFP(O_HID), BFP(O_L2T), 256, 512, S, E);
            EpiBf<4> E2{BFP(SLOTP(2)), nullptr, 0, a.in[18], nullptr}; gemm_phase(lds, BFP(O_HID), BFP(O_L2T + 512 * 1024), 256, 512, S, E2); } } }
        if (10 + 1 < a.ph_hi) GSYNC(); }
    if (a.ph_lo <= 11 && 11 < a.ph_hi) { if (ONLY < 0 || ONLY == 11) { for (int rep_ = 0; rep_ < (DUP == 11 ? 2 : 1); ++rep_) { if (rep_) GSYNC(); scan_phase(a, lds); } }
        if (11 + 1 < a.ph_hi) GSYNC(); }
    if (a.ph_lo <= 12 && 12 < a.ph_hi) { if (ONLY < 0 || ONLY == 12) { for (int rep_ = 0; rep_ < (DUP == 12 ? 2 : 1); ++rep_) { if (rep_) GSYNC(); { StaticOrder S{64, 4, 512, 512}; EpiBf<0> E{BFP(SLOTP(4)), nullptr, 0, nullptr, nullptr}; gemm_phase(lds, BFP(O_HID), BFP(O_L2T + 1 * MiB), 256, 512, S, E); } } }
        if (12 + 1 < a.ph_hi) GSYNC(); }
    if (a.ph_lo <= 13 && 13 < a.ph_hi) { if (ONLY < 0 || ONLY == 13) { for (int rep_ = 0; rep_ < (DUP == 13 ? 2 : 1); ++rep_) { if (rep_) GSYNC(); post_phase(a); } }
        if (13 + 1 < a.ph_hi) GSYNC(); }
    if (a.ph_lo <= 14 && 14 < a.ph_hi) { if (ONLY < 0 || ONLY == 14) { for (int rep_ = 0; rep_ < (DUP == 14 ? 2 : 1); ++rep_) { if (rep_) GSYNC(); { StaticOrder S{64, 4, 2048, 2048}; EpiRes E{a.out, a.out, nullptr}; gemm_phase(lds, BFP(SLOTP(5)), BFP(O_WOT), 1024, 2048, S, E); } } }
        if (14 + 1 < a.ph_hi) GSYNC(); }
    if (a.ph_lo <= 15 && 15 < a.ph_hi) { if (ONLY < 0 || ONLY == 15) { for (int rep_ = 0; rep_ < (DUP == 15 ? 2 : 1); ++rep_) { if (rep_) GSYNC(); ln_phase(a.out, a.out, BFP(SLOTP(0)), a.in[31] + 1024, a.in[32] + 1024); } }
        if (15 + 1 < a.ph_hi) GSYNC(); }
    if (a.ph_lo <= 16 && 16 < a.ph_hi) { if (ONLY < 0 || ONLY == 16) { for (int rep_ = 0; rep_ < (DUP == 16 ? 2 : 1); ++rep_) { if (rep_) GSYNC(); { StaticOrder S{64, 22, 2048, 2048}; EpiSwiglu E{BFP(SLOTP(1))}; gemm_phase(lds, BFP(SLOTP(0)), BFP(O_F1T1), 1024, 2048, S, E); } } }
        if (16 + 1 < a.ph_hi) GSYNC(); }
    if (a.ph_lo <= 17 && 17 < a.ph_hi) { if (ONLY < 0 || ONLY == 17) { for (int rep_ = 0; rep_ < (DUP == 17 ? 2 : 1); ++rep_) { if (rep_) GSYNC(); { StaticOrder S{64, 4, 2 * FH, 2 * FH}; EpiRes E{a.out, a.out, nullptr}; gemm_phase(lds, BFP(SLOTP(1)), BFP(O_F2T1), FH, 2 * FH, S, E); } } }
        if (17 + 1 < a.ph_hi) GSYNC(); }
    if (a.ph_lo <= 18 && 18 < a.ph_hi) { if (ONLY < 0 || ONLY == 18) { for (int rep_ = 0; rep_ < (DUP == 18 ? 2 : 1); ++rep_) { if (rep_) GSYNC(); ln_phase(a.out, a.out, nullptr, a.in[33] + 1024, a.in[34] + 1024); } }
        if (18 + 1 < a.ph_hi) GSYNC(); }
    if (a.ph_lo <= 19 && 19 < a.ph_hi) { const bf16_t* src = BFP(DUMP_OFF); const int t0 = tid_opaque();
        for (size_t i = (size_t)blockIdx.x * 512 + t0; i < (size_t)MT * DM; i += (size_t)gridDim.x * 512) a.out[i] = bf2f(src[i]); }
#ifdef EXTRA_SYNCS
    if (a.ph_hi == NPHASE) { for (int i = 0; i < 16; ++i) grid.sync(); }
#endif
#undef BFP
}

extern "C" void kernel_launch(void* const* d_in, const int* in_sizes, int n_in, void* d_out, int out_size, void* d_ws, size_t ws_size, hipStream_t stream) {
    static int grid_blocks = 0;
    if (grid_blocks == 0) {
        if (n_in != 35 || out_size != MT * DM || ws_size < WS_END) { fprintf(stderr, "kernel_launch: unexpected shapes (n_in %d out %d ws %zu need %zu)\n", n_in, out_size, ws_size, (size_t)WS_END); grid_blocks = -1; return; }
        int dev = 0, cus = 0, per_cu = 0;
        hipGetDevice(&dev); hipDeviceGetAttribute(&cus, hipDeviceAttributeMultiprocessorCount, dev);
        hipFuncSetAttribute((const void*)mk_fwd, hipFuncAttributeMaxDynamicSharedMemorySize, STAGE_BYTES);
        hipOccupancyMaxActiveBlocksPerMultiprocessor(&per_cu, (const void*)mk_fwd, 512, STAGE_BYTES);
        if (per_cu < 1) per_cu = 1;
        grid_blocks = cus * per_cu;
        if (grid_blocks > 256) grid_blocks = 256;
    }
    if (grid_blocks < 0) return;
    if (hipMemsetAsync((char*)d_ws + O_BAR, 0, 256, stream) != hipSuccess) { fprintf(stderr, "kernel_launch: memset of barrier words failed\n"); return; }
    Args a{};
    for (int i = 0; i < 35; ++i) a.in[i] = (const float*)d_in[i];
    a.out = (float*)d_out; a.ws = (unsigned char*)d_ws;
#if PER_PHASE_LAUNCH
    for (int ph = 0; ph < NPHASE && ph <= STOP_AFTER; ++ph) {
        a.ph_lo = ph; a.ph_hi = ph + 1; void* args[] = {&a};
        hipError_t e = hipLaunchCooperativeKernel((const void*)mk_fwd, dim3(grid_blocks), dim3(512), args, STAGE_BYTES, stream);
        if (e != hipSuccess) { fprintf(stderr, "cooperative launch failed: %s\n", hipGetErrorString(e)); return; }
    }
    if (STOP_AFTER < NPHASE - 1) { a.ph_lo = 19; a.ph_hi = 20; void* args[] = {&a};
        (void)hipLaunchCooperativeKernel((const void*)mk_fwd, dim3(grid_blocks), dim3(512), args, STAGE_BYTES, stream); }
#else
    a.ph_lo = 0; a.ph_hi = NPHASE; void* args[] = {&a};
    hipError_t e = hipLaunchCooperativeKernel((const void*)mk_fwd, dim3(grid_blocks), dim3(512), args, STAGE_BYTES, stream);
    if (e != hipSuccess) fprintf(stderr, "cooperative launch failed: %s (grid %d)\n", hipGetErrorString(e), grid_blocks);
#endif
}
```

```cpp
#include <hip/hip_runtime.h>
#include <hip/hip_cooperative_groups.h>
#include <cstdio>
namespace cg = cooperative_groups;

#ifndef PER_PHASE_LAUNCH
#define PER_PHASE_LAUNCH 0
#endif

#ifndef STOP_AFTER
#define STOP_AFTER 99
#endif
#ifndef DUMP_OFF
#define DUMP_OFF SLOTP(2)
#endif
#ifndef DUP
#define DUP -1
#endif
#ifndef ONLY
#define ONLY -1
#endif
#define LAS __attribute__((address_space(3)))
typedef unsigned short bf16_t;
typedef short bf16x8 __attribute__((ext_vector_type(8)));
typedef float f32x4 __attribute__((ext_vector_type(4)));
typedef unsigned u32x4 __attribute__((ext_vector_type(4)));
typedef unsigned u32x2 __attribute__((ext_vector_type(2)));

constexpr int MT = 16384, DM = 1024, SEQL = 4096, FH = 2816;
constexpr float ALPHA = 1.41421356237f;
constexpr size_t MiB = 1ull << 20;
constexpr size_t O_WRKV = 0;
constexpr size_t O_WL1 = 6 * MiB;
constexpr size_t O_L2T = 7 * MiB;
constexpr size_t O_WOT = 8 * MiB + 512 * 1024;
constexpr size_t O_F1T1 = 10 * MiB + 512 * 1024;
constexpr size_t O_F2T1 = 21 * MiB + 512 * 1024;
constexpr size_t O_W1T = 27 * MiB;
constexpr size_t O_W2T = 31 * MiB;
constexpr size_t O_F1T0 = 33 * MiB;
constexpr size_t O_F2T0 = 44 * MiB;
constexpr size_t O_CT = 50 * MiB;
constexpr size_t O_BAR = 51 * MiB;
constexpr size_t O_SLOT = 52 * MiB;
constexpr size_t SLOT = 32 * MiB + 64 * 1024;
constexpr size_t O_HID = O_SLOT + 6 * SLOT;
constexpr size_t WS_END = O_HID + 8 * MiB;
#define SLOTP(i) (O_SLOT + (size_t)(i) * SLOT)

struct Args { const float* in[35]; float* out; unsigned char* ws; int ph_lo, ph_hi; };

__device__ __forceinline__ float bf2f(bf16_t v) { return __uint_as_float((unsigned)v << 16); }
typedef float f32x2 __attribute__((ext_vector_type(2)));
typedef __bf16 bf16x2n __attribute__((ext_vector_type(2)));
__device__ __forceinline__ unsigned cvt_pk_bf16(float lo, float hi) { const f32x2 v = {lo, hi}; return __builtin_bit_cast(unsigned, __builtin_convertvector(v, bf16x2n)); }
__device__ __forceinline__ bf16_t f2bf(float f) { return (bf16_t)(cvt_pk_bf16(f, 0.f) & 0xffffu); }
__device__ __forceinline__ float sigmoidf_(float z) { return __builtin_amdgcn_rcpf(1.0f + __expf(-z)); }
__device__ __forceinline__ float gelu_tanh(float x) { return x * sigmoidf_(1.5957691216f * (x + 0.044715f * x * x * x)); }
__device__ __forceinline__ int tid_opaque() { int t = threadIdx.x; asm volatile("" : "+v"(t)); return t; }
template <int CTRL> __device__ __forceinline__ float dpp_mov(float v) { return __int_as_float(__builtin_amdgcn_update_dpp(0, __float_as_int(v), CTRL, 0xF, 0xF, true)); }
__device__ __forceinline__ float red16(float v) { v += dpp_mov<0xB1>(v); v += dpp_mov<0x4E>(v); v += dpp_mov<0x141>(v); v += dpp_mov<0x140>(v); return v; }
__device__ __forceinline__ float wave_sum(float v) {
    v = red16(v);
    return ((__int_as_float(__builtin_amdgcn_readlane(__float_as_int(v), 0)) + __int_as_float(__builtin_amdgcn_readlane(__float_as_int(v), 16))) + (__int_as_float(__builtin_amdgcn_readlane(__float_as_int(v), 32)) + __int_as_float(__builtin_amdgcn_readlane(__float_as_int(v), 48))));
}
__device__ __forceinline__ float wave_sum_old(float v) {
#pragma unroll
    for (int o = 32; o; o >>= 1) v += __shfl_xor(v, o);
    return v;
}
__device__ __forceinline__ u32x2 pack4(f32x4 v) { u32x2 w; w.x = cvt_pk_bf16(v[0], v[1]); w.y = cvt_pk_bf16(v[2], v[3]); return w; }
__device__ __forceinline__ void unpack8(u32x4 r, float (&f)[8]) {
#pragma unroll
    for (int i = 0; i < 4; ++i) { f[2 * i] = __uint_as_float(r[i] << 16); f[2 * i + 1] = __uint_as_float(r[i] & 0xffff0000u); }
}

constexpr int BM = 256, BK = 64, HALF = 128, HTB = HALF * BK * 2, STAGE_BYTES = 8 * HTB, NXCD = 8, WGM = 8;
__device__ __forceinline__ int lds_byte(int r, int c) { const int st = (r >> 4) * 2 + (c >> 5), rr = r & 15, cc = c & 31, ob = rr * 64 + cc * 2; return st * 1024 + (ob ^ (((ob >> 9) & 1) << 5)); }
__device__ __forceinline__ void stage_rc(int b, int& R, int& C) { const int st = b / 1024, sb = b % 1024, swz = sb ^ (((sb >> 9) & 1) << 5); R = (st >> 1) * 16 + swz / 64; C = (st & 1) * 32 + (swz % 64) / 2; }

struct Unit { int pm, pn, tag; size_t aoff, boff; };
__device__ __forceinline__ void remap_tile(int wgid, int nM, int nN, int& pm, int& pn) {
    const int nwg = nM * nN;
    { const int q = nwg / NXCD, r = nwg % NXCD, xcd = wgid % NXCD, off = wgid / NXCD; wgid = (xcd < r ? xcd * (q + 1) : r * (q + 1) + (xcd - r) * q) + off; }
    const int nig = WGM * nN, gid = wgid / nig, fm = gid * WGM, gsz = (nM - fm) < WGM ? (nM - fm) : WGM;
    pm = fm + ((wgid % nig) % gsz); pn = (wgid % nig) / gsz;
}
struct StaticOrder {
    int nM, nN; size_t ldaB, ldbB;
    __device__ __forceinline__ bool next(int i, Unit& u) const {
        const long L = (long)i * gridDim.x + blockIdx.x; if (L >= (long)nM * nN) return false;
        remap_tile((int)L, nM, nN, u.pm, u.pn); u.tag = 0; u.aoff = (size_t)u.pm * BM * ldaB; u.boff = (size_t)u.pn * BM * ldbB; return true;
    }
};
struct GroupOrder {
    int ngr; size_t astride;
    __device__ __forceinline__ bool next(int i, Unit& u) const {
        const long L = (long)i * gridDim.x + blockIdx.x; if (L >= (long)ngr * 256) return false;
        const int g = (int)(L >> 8); remap_tile((int)(L & 255), 64, 4, u.pm, u.pn); u.tag = g;
        u.aoff = (size_t)g * astride + (size_t)u.pm * BM * 2048; u.boff = (size_t)(g * 4 + u.pn) * BM * 2048; return true;
    }
};
struct LoraOrder {
    __device__ __forceinline__ bool next(int i, Unit& u) const {
        const long L = (long)i * gridDim.x + blockIdx.x; if (L >= 64) return false;
        u.pm = (int)L; u.pn = 0; u.tag = 0; u.aoff = (size_t)(256 * u.pm + (u.pm >> 4)) * 2048; u.boff = 0; return true;
    }
};

#define EPI_ROWS(ai, m) (u.pm * BM + (ai) * HALF + wr * 64 + (m) * 16 + fr)
#define EPI_CL(n) (wc * 32 + (n) * 16 + 4 * fq)
typedef f32x4 AccT[2][2][4][2];

struct EpiG1 {
    bf16_t* ypre; bf16_t* ug; bf16_t* vg; const float* bias;
    __device__ __forceinline__ void operator()(const AccT& acc, const Unit& u, int wr, int wc, int fr, int fq) const {
        if (u.pn < 4) {
#pragma unroll
            for (int n = 0; n < 2; ++n) {
                const int cl = EPI_CL(n); const f32x4 bv = *(const f32x4*)(bias + 128 * u.pn + cl), bg = *(const f32x4*)(bias + 512 + 128 * u.pn + cl);
#pragma unroll
                for (int ai = 0; ai < 2; ++ai)
#pragma unroll
                    for (int m = 0; m < 4; ++m) { const f32x4 val = acc[ai][0][m][n] + bv, gate = acc[ai][1][m][n] + bg; f32x4 y;
#pragma unroll
                        for (int j = 0; j < 4; ++j) y[j] = val[j] * sigmoidf_(gate[j]);
                        *(u32x2*)(ypre + (size_t)EPI_ROWS(ai, m) * 512 + 128 * u.pn + cl) = pack4(y); }
            }
        } else {
            bf16_t* dst = u.pn < 6 ? ug : vg; const int cb = (u.pn & 1) * 256;
#pragma unroll
            for (int bj = 0; bj < 2; ++bj)
#pragma unroll
                for (int n = 0; n < 2; ++n) {
                    const int cl = bj * HALF + EPI_CL(n); const f32x4 bv = *(const f32x4*)(bias + 256 * u.pn + cl);
#pragma unroll
                    for (int ai = 0; ai < 2; ++ai)
#pragma unroll
                        for (int m = 0; m < 4; ++m) { const f32x4 v = acc[ai][bj][m][n] + bv; f32x4 y;
#pragma unroll
                            for (int j = 0; j < 4; ++j) y[j] = gelu_tanh(v[j]);
                            *(u32x2*)(dst + (size_t)EPI_ROWS(ai, m) * 512 + cb + cl) = pack4(y); }
                }
        }
    }
};
struct EpiRes {
    const float* res; float* out; const float* bias;
    __device__ __forceinline__ void operator()(const AccT& acc, const Unit& u, int wr, int wc, int fr, int fq) const {
#pragma unroll
        for (int bj = 0; bj < 2; ++bj)
#pragma unroll
            for (int n = 0; n < 2; ++n) {
                const int col = u.pn * BM + bj * HALF + EPI_CL(n); const f32x4 bv = bias ? *(const f32x4*)(bias + col) : (f32x4){0.f, 0.f, 0.f, 0.f};
#pragma unroll
                for (int ai = 0; ai < 2; ++ai)
#pragma unroll
                    for (int m = 0; m < 4; ++m) { const size_t off = (size_t)EPI_ROWS(ai, m) * DM + col; const f32x4 r4 = *(const f32x4*)(res + off);
                        *(f32x4*)(out + off) = r4 * ALPHA + acc[ai][bj][m][n] + bv; }
            }
    }
};
struct EpiSwiglu {
    bf16_t* hmid;
    __device__ __forceinline__ void operator()(const AccT& acc, const Unit& u, int wr, int wc, int fr, int fq) const {
#pragma unroll
        for (int n = 0; n < 2; ++n) {
            const int col = 128 * u.pn + EPI_CL(n);
#pragma unroll
            for (int ai = 0; ai < 2; ++ai)
#pragma unroll
                for (int m = 0; m < 4; ++m) { const f32x4 g = acc[ai][0][m][n], up = acc[ai][1][m][n]; f32x4 y;
#pragma unroll
                    for (int j = 0; j < 4; ++j) y[j] = g[j] * sigmoidf_(g[j]) * up[j];
                    *(u32x2*)(hmid + (size_t)EPI_ROWS(ai, m) * FH + col) = pack4(y); }
        }
    }
};
template <int MODE> struct EpiBf {
    bf16_t* dst; bf16_t* dst2; size_t gstride; const float* p0; const float* p1;
    __device__ __forceinline__ void operator()(const AccT& acc, const Unit& u, int wr, int wc, int fr, int fq) const {
#pragma unroll
        for (int bj = 0; bj < 2; ++bj)
#pragma unroll
            for (int n = 0; n < 2; ++n) {
                const int col = u.pn * BM + bj * HALF + EPI_CL(n);
                f32x4 pv = (f32x4){0.f, 0.f, 0.f, 0.f};
                if (MODE == 2 || MODE == 4) pv = *(const f32x4*)(p0 + col);
#pragma unroll
                for (int ai = 0; ai < 2; ++ai)
#pragma unroll
                    for (int m = 0; m < 4; ++m) {
                        const size_t row = (size_t)EPI_ROWS(ai, m); f32x4 v = acc[ai][bj][m][n];
                        if (MODE == 0) { *(u32x2*)(dst + (size_t)u.tag * gstride + row * DM + col) = pack4(v); }
                        if (MODE == 3) { *(u32x2*)(dst + row * 512 + col) = pack4(v); }
                        if (MODE == 1) {
                            if (col < 64) {
#pragma unroll
                                for (int j = 0; j < 4; ++j) v[j] = 2.0f * sigmoidf_(2.0f * v[j]) - 1.0f;
                            } else if (col >= 128) {
#pragma unroll
                                for (int j = 0; j < 4; ++j) v[j] = sigmoidf_(v[j]);
                            }
                            *(u32x2*)(dst + row * 256 + col) = pack4(v);
                        }
                        if (MODE == 2) {
                            v += pv;
#pragma unroll
                            for (int j = 0; j < 4; ++j) v[j] = 0.60653066f * sigmoidf_(v[j]);
                            *(u32x2*)(dst + row * DM + col) = pack4(v);
                        }
                        if (MODE == 4) {
                            v += pv;
#pragma unroll
                            for (int j = 0; j < 4; ++j) v[j] = sigmoidf_(v[j]);
                            *(u32x2*)(dst + row * DM + col) = pack4(v);
                        }
                    }
            }
    }
};

template <class Epi, class Sched>
__device__ __forceinline__ void gemm_phase(LAS unsigned char* lds, const bf16_t* Ap, const bf16_t* Btp, const int K, const size_t ldaB, const Sched& S, const Epi& E) {
    int tid = threadIdx.x; asm volatile("" : "+v"(tid));
    const int wid = __builtin_amdgcn_readfirstlane(tid >> 6), lane = tid & 63, wr = wid >> 2, wc = wid & 3, fr = lane & 15, fq = lane >> 4;
    const int nt = K / BK;
    unsigned voffA[2], voffB[2];
#pragma unroll
    for (int i = 0; i < 2; ++i) { int R, C; stage_rc(tid * 16 + i * 8192, R, C); voffA[i] = (unsigned)(R * (int)ldaB + C * 2); voffB[i] = (unsigned)(R * K + C) * 2u; }
    const size_t kstep = (size_t)(BK * 2);
    const size_t hA = (size_t)HALF * ldaB, hB = (size_t)HALF * K * 2;
    const unsigned ldsw = (unsigned)wid * 1024u;
    const int aoff = lds_byte(wr * 64 + fr, fq * 8), boff = lds_byte(wc * 32 + fr, fq * 8);
#define G_SA(b, h) (((b) * 2 + (h)) * HTB)
#define G_SB(b, h) ((4 + (b) * 2 + (h)) * HTB)
#define G_STAGE(bufoff, gbase, voff) do { _Pragma("unroll") for (int _i = 0; _i < 2; ++_i) \
        __builtin_amdgcn_global_load_lds((const unsigned*)((const char*)(gbase) + (voff)[_i]), (LAS unsigned*)(lds + (bufoff) + ldsw + _i * 8192), 16, 0, 0); } while (0)
#define G_LDA(dst, b, h) do { _Pragma("unroll") for (int m = 0; m < 4; ++m) _Pragma("unroll") for (int k = 0; k < 2; ++k) dst[m][k] = *(const LAS bf16x8*)(lds + G_SA(b, h) + aoff + m * 2048 + k * 1024); } while (0)
#define G_LDB(dst, b, h) do { _Pragma("unroll") for (int n = 0; n < 2; ++n) _Pragma("unroll") for (int k = 0; k < 2; ++k) dst[n][k] = *(const LAS bf16x8*)(lds + G_SB(b, h) + boff + n * 2048 + k * 1024); } while (0)
#define G_MMA(ai, bj, At, Bt) do { __builtin_amdgcn_s_setprio(1); _Pragma("unroll") for (int m = 0; m < 4; ++m) _Pragma("unroll") for (int n = 0; n < 2; ++n) _Pragma("unroll") for (int k = 0; k < 2; ++k) \
        acc[ai][bj][m][n] = __builtin_amdgcn_mfma_f32_16x16x32_bf16(Bt[n][k], At[m][k], acc[ai][bj][m][n], 0, 0, 0); __builtin_amdgcn_s_setprio(0); } while (0)
#define G_WAIT_V(n) asm volatile("s_waitcnt vmcnt(" #n ")" ::: "memory")
#define G_WAIT_L(n) asm volatile("s_waitcnt lgkmcnt(" #n ")" ::: "memory")
#define G_BAR __builtin_amdgcn_s_barrier()
#define G_SCHED __builtin_amdgcn_sched_barrier(0)
    Unit cur, nxt; int ui = 0;
    if (!S.next(0, cur)) return;
    f32x4 acc[2][2][4][2];
#pragma unroll
    for (int a = 0; a < 2; ++a)
#pragma unroll
        for (int b = 0; b < 2; ++b)
#pragma unroll
            for (int m = 0; m < 4; ++m)
#pragma unroll
                for (int n = 0; n < 2; ++n) acc[a][b][m][n] = (f32x4){0.f, 0.f, 0.f, 0.f};
    bf16x8 At[4][2], B0[2][2], B1[2][2];
    const char* cA = (const char*)Ap + cur.aoff; const char* cB = (const char*)Btp + cur.boff;
    G_STAGE(G_SB(0, 0), cB, voffB); G_STAGE(G_SA(0, 0), cA, voffA); G_STAGE(G_SB(0, 1), cB + hB, voffB); G_STAGE(G_SA(0, 1), cA + hA, voffA);
    if (wr == 1) G_BAR;
    G_WAIT_V(4); G_BAR;
    G_STAGE(G_SB(1, 0), cB + kstep, voffB); G_STAGE(G_SA(1, 0), cA + kstep, voffA); G_STAGE(G_SB(1, 1), cB + hB + kstep, voffB);
    G_WAIT_V(6); G_BAR;
    for (;;) {
        const bool has_next = S.next(ui + 1, nxt);
        const char* nA = has_next ? (const char*)Ap + nxt.aoff : cA; const char* nB = has_next ? (const char*)Btp + nxt.boff : cB;
        for (int t = 0; t < nt; t += 2) {
            const bool last = (t == nt - 2);
            const char* a1 = cA + (size_t)(t + 1) * kstep;
            const char* a2 = last ? nA : cA + (size_t)(t + 2) * kstep; const char* b2 = last ? nB : cB + (size_t)(t + 2) * kstep;
            const char* a3 = a2 + kstep; const char* b3 = b2 + kstep;
            G_LDB(B0, 0, 0); G_SCHED; G_LDA(At, 0, 0); G_STAGE(G_SA(1, 1), a1 + hA, voffA);
            G_WAIT_L(8); G_BAR; G_WAIT_L(0); G_MMA(0, 0, At, B0); G_BAR; G_SCHED;
            G_LDB(B1, 0, 1); G_STAGE(G_SB(0, 0), b2, voffB);
            G_BAR; G_WAIT_L(0); G_MMA(0, 1, At, B1); G_BAR;
            G_LDA(At, 0, 1); G_STAGE(G_SA(0, 0), a2, voffA);
            G_BAR; G_WAIT_L(0); G_MMA(1, 0, At, B0); G_BAR; G_SCHED;
            G_STAGE(G_SB(0, 1), b2 + hB, voffB);
            G_WAIT_V(6); G_BAR; G_MMA(1, 1, At, B1); G_BAR;
            G_LDB(B0, 1, 0); G_SCHED; G_LDA(At, 1, 0); G_STAGE(G_SA(0, 1), a2 + hA, voffA);
            G_WAIT_L(8); G_BAR; G_WAIT_L(0); G_MMA(0, 0, At, B0); G_BAR; G_SCHED;
            G_LDB(B1, 1, 1); G_STAGE(G_SB(1, 0), b3, voffB);
            G_BAR; G_WAIT_L(0); G_MMA(0, 1, At, B1); G_BAR;
            G_LDA(At, 1, 1); G_STAGE(G_SA(1, 0), a3, voffA);
            G_BAR; G_WAIT_L(0); G_MMA(1, 0, At, B0); G_BAR; G_SCHED;
            G_STAGE(G_SB(1, 1), b3 + hB, voffB);
            G_WAIT_V(6); G_BAR; G_MMA(1, 1, At, B1); G_BAR;
        }
        E(acc, cur, wr, wc, fr, fq);
        if (!has_next) break;
#pragma unroll
        for (int a = 0; a < 2; ++a)
#pragma unroll
            for (int b = 0; b < 2; ++b)
#pragma unroll
                for (int m = 0; m < 4; ++m)
#pragma unroll
                    for (int n = 0; n < 2; ++n) acc[a][b][m][n] = (f32x4){0.f, 0.f, 0.f, 0.f};
        cur = nxt; cA = nA; cB = nB; ++ui;
    }
    G_WAIT_V(0);
    if (wr == 0) G_BAR;
    G_BAR;
#undef G_SA
#undef G_SB
#undef G_STAGE
#undef G_LDA
#undef G_LDB
#undef G_MMA
#undef G_WAIT_V
#undef G_WAIT_L
#undef G_BAR
#undef G_SCHED
}

__device__ void prep_phase(const Args& a, LAS unsigned char* lds) {
    LAS float* tile = (LAS float*)lds;
    const int tid0 = tid_opaque(); const int tx = tid0 & 63, ty = tid0 >> 6;
    constexpr int T0 = 768, T1 = T0 + 128, T2 = T1 + 192, T3 = T2 + 256, T4 = T3 + 1408, T5 = T4 + 704, T6 = T5 + 512, T7 = T6 + 256, T8 = T7 + 1408, T9 = T8 + 704;
    for (int t = blockIdx.x; t < T9; t += gridDim.x) {
        int mat, lt, kt; size_t doff; int Kd;
        if (t < T0) { mat = 0; lt = t; kt = 16; doff = O_WRKV; Kd = 1024; }
        else if (t < T1) { mat = 1; lt = t - T0; kt = 16; doff = O_WL1; Kd = 1024; }
        else if (t < T2) { mat = 2; lt = t - T1; kt = 4; doff = O_L2T; Kd = 256; }
        else if (t < T3) { mat = 3; lt = t - T2; kt = 16; doff = O_WOT; Kd = 1024; }
        else if (t < T4) { mat = 4; lt = t - T3; kt = 16; doff = O_F1T1; Kd = 1024; }
        else if (t < T5) { mat = 5; lt = t - T4; kt = 44; doff = O_F2T1; Kd = FH; }
        else if (t < T6) { mat = 6; lt = t - T5; kt = 16; doff = O_W1T; Kd = 1024; }
        else if (t < T7) { mat = 7; lt = t - T6; kt = 16; doff = O_W2T; Kd = 1024; }
        else if (t < T8) { mat = 8; lt = t - T7; kt = 16; doff = O_F1T0; Kd = 1024; }
        else { mat = 9; lt = t - T8; kt = 44; doff = O_F2T0; Kd = FH; }
        const int n0 = (lt / kt) * 64, k0 = (lt % kt) * 64;
        const float* base = nullptr; int ld = 1024, mode = 0; const float* mup = a.in[13];
        if (mat == 0) { base = a.in[14] + ((size_t)(n0 >> 10) * 1024 + k0) * 1024 + (n0 & 1023); }
        else if (mat == 1) { const int nn = n0 & 255; int mi;
            if (nn < 64) { base = a.in[16] + (size_t)k0 * 64; ld = 64; mi = 1; } else if (nn < 128) { base = a.in[19] + (size_t)k0 * 64; ld = 64; mi = 4; } else { base = a.in[21] + (size_t)k0 * 128 + (nn - 128); ld = 128; mi = 5; }
            mode = (n0 >= 256) ? 1 : 2; mup = a.in[13] + mi * 1024 + k0; }
        else if (mat == 2) {
            if (n0 < 1024) { if (k0 == 0) base = a.in[17] + n0; else mode = 3; }
            else if (n0 < 2048) { if (k0 == 64) base = a.in[20] + (n0 - 1024); else mode = 3; }
            else { if (k0 >= 128) base = a.in[22] + (size_t)(k0 - 128) * 1024 + (n0 - 2048); else mode = 3; } }
        else if (mat == 3) { base = a.in[28] + (size_t)k0 * 1024 + n0; }
        else if (mat == 4 || mat == 8) { const int pn = n0 >> 8, r = n0 & 255; const int col0 = (r < 128) ? 128 * pn + r : FH + 128 * pn + r - 128; ld = 2 * FH;
            base = a.in[29] + (size_t)(mat == 4 ? 1 : 0) * 1024 * 2 * FH + (size_t)k0 * 2 * FH + col0; }
        else if (mat == 5 || mat == 9) { base = a.in[30] + (size_t)(mat == 5 ? 1 : 0) * FH * 1024 + (size_t)k0 * 1024 + n0; }
        else if (mat == 6) { const int pn = n0 >> 8, r = n0 & 255; const int col0 = (pn < 4) ? ((r < 128) ? 128 * pn + r : 512 + 128 * pn + r - 128) : n0; ld = 2048; base = a.in[1] + (size_t)k0 * 2048 + col0; }
        else { base = a.in[11] + (size_t)k0 * 1024 + n0; }
        if (mode == 3) {
#pragma unroll
            for (int i = 0; i < 8; ++i) tile[(ty + 8 * i) * 65 + tx] = 0.f;
        } else {
            float v[8];
#pragma unroll
            for (int i = 0; i < 8; ++i) v[i] = base[(size_t)(ty + 8 * i) * ld + tx];
            if (mode == 1) {
#pragma unroll
                for (int i = 0; i < 8; ++i) v[i] *= mup[ty + 8 * i];
            } else if (mode == 2) {
#pragma unroll
                for (int i = 0; i < 8; ++i) v[i] *= (1.0f - mup[ty + 8 * i]);
            }
#pragma unroll
            for (int i = 0; i < 8; ++i) tile[(ty + 8 * i) * 65 + tx] = v[i];
        }
        __syncthreads();
        bf16_t* dst = (bf16_t*)(a.ws + doff);
        const int kq = tid0 & 15, nr = tid0 >> 4;
#pragma unroll
        for (int i = 0; i < 2; ++i) { const int n = nr + 32 * i;
            f32x4 w; w[0] = tile[(4 * kq + 0) * 65 + n]; w[1] = tile[(4 * kq + 1) * 65 + n]; w[2] = tile[(4 * kq + 2) * 65 + n]; w[3] = tile[(4 * kq + 3) * 65 + n];
            *(u32x2*)(dst + (size_t)(n0 + n) * Kd + k0 + 4 * kq) = pack4(w); }
        __syncthreads();
    }
    const float* x = a.in[0]; bf16_t* xb = (bf16_t*)(a.ws + SLOTP(0));
    for (size_t i = (size_t)blockIdx.x * 512 + tid0; i < (size_t)MT * DM / 4; i += (size_t)gridDim.x * 512) {
        const f32x4 v = *(const f32x4*)(x + 4 * i); *(u32x2*)(xb + 4 * i) = pack4(v);
    }
}

__device__ void conv_tile(const Args& a, LAS unsigned char* lds, int tile) {
    LAS bf16_t* in = (LAS bf16_t*)lds;
    LAS float* outf = (LAS float*)(lds + 63488);
    const bf16_t* ypre = (const bf16_t*)(a.ws + SLOTP(1));
    bf16_t* mixed = (bf16_t*)(a.ws + SLOTP(3));
    const int tid = tid_opaque(), wid = tid >> 6, lane = tid & 63;
    const int m0 = tile * 32, s0 = m0 & (SEQL - 1);
    for (int v = tid; v < 62 * 64; v += 512) {
        const int r = v >> 6, cv = v & 63; u32x4 val = (u32x4){0u, 0u, 0u, 0u};
        if (s0 - 30 + r >= 0) val = *(const u32x4*)(ypre + (size_t)(m0 - 30 + r) * 512 + cv * 8);
        *(LAS u32x4*)(in + r * 512 + cv * 8) = val;
    }
    __syncthreads();
    {
        const int c = tid; const float* cwp = a.in[3]; float cw[31];
#pragma unroll
        for (int w = 0; w < 31; ++w) cw[w] = cwp[w * 512 + c];
        const float cb = a.in[4][c];
        float xin[62];
#pragma unroll
        for (int r = 0; r < 62; ++r) xin[r] = bf2f(in[r * 512 + c]);
#pragma unroll
        for (int tt = 0; tt < 32; ++tt) { float s = cb;
#pragma unroll
            for (int w = 0; w < 31; ++w) s += xin[tt + w] * cw[w];
            outf[tt * 512 + c] = s; }
    }
    __syncthreads();
    {
        const float* g = a.in[5]; const float* b = a.in[6];
        const f32x4 g0 = *(const f32x4*)(g + 4 * lane), g1 = *(const f32x4*)(g + 256 + 4 * lane), b0 = *(const f32x4*)(b + 4 * lane), b1 = *(const f32x4*)(b + 256 + 4 * lane);
        for (int tt = wid; tt < 32; tt += 8) {
            f32x4 v0 = *(const LAS f32x4*)(outf + tt * 512 + 4 * lane), v1 = *(const LAS f32x4*)(outf + tt * 512 + 256 + 4 * lane);
            float s = (v0[0] + v0[1]) + (v0[2] + v0[3]) + (v1[0] + v1[1]) + (v1[2] + v1[3]);
            const float mean = wave_sum(s) * (1.0f / 512.0f);
            v0 -= mean; v1 -= mean;
            float q = v0[0] * v0[0] + v0[1] * v0[1] + v0[2] * v0[2] + v0[3] * v0[3] + v1[0] * v1[0] + v1[1] * v1[1] + v1[2] * v1[2] + v1[3] * v1[3];
            const float rstd = rsqrtf(wave_sum(q) * (1.0f / 512.0f) + 1e-5f);
            v0 = v0 * rstd * g0 + b0; v1 = v1 * rstd * g1 + b1;
#pragma unroll
            for (int j = 0; j < 4; ++j) { v0[j] = v0[j] * sigmoidf_(v0[j]); v1[j] = v1[j] * sigmoidf_(v1[j]); }
            bf16_t* o = mixed + (size_t)(m0 + tt) * DM;
            *(u32x2*)(o + 4 * lane) = pack4(v0); *(u32x2*)(o + 256 + 4 * lane) = pack4(v1);
        }
    }
    __syncthreads();
}
__device__ void sgu_item(const Args& a, LAS unsigned char* lds, int item) {
    LAS bf16_t* Wl = (LAS bf16_t*)lds;
    LAS bf16_t* VT = (LAS bf16_t*)(lds + 34816);
    LAS float* st = (LAS float*)(lds + 69632);
    const bf16_t* ug = (const bf16_t*)(a.ws + SLOTP(1) + 16 * MiB);
    const bf16_t* vg = (const bf16_t*)(a.ws + SLOTP(2));
    bf16_t* mixed = (bf16_t*)(a.ws + SLOTP(3));
    const int tid = tid_opaque(), wid = tid >> 6, lane = tid & 63;
    const int g = item & 3, m0 = (item >> 2) * 128;
    for (int i = 0; i < 16; ++i) {
        const int tok = 16 * wid + i; float f[8]; unpack8(*(const u32x4*)(vg + (size_t)(m0 + tok) * 512 + lane * 8), f);
        float s = 0.f;
#pragma unroll
        for (int e = 0; e < 8; ++e) s += f[e];
        const float mean = wave_sum(s) * (1.0f / 512.0f); float q = 0.f;
#pragma unroll
        for (int e = 0; e < 8; ++e) { const float d = f[e] - mean; q += d * d; }
        const float rstd = rsqrtf(wave_sum(q) * (1.0f / 512.0f) + 1e-5f);
        if (lane == 0) { st[2 * tok] = mean; st[2 * tok + 1] = rstd; }
    }
    __syncthreads();
    {
        const int s = tid & 127, dq = tid >> 7; const float mean = st[2 * s], rstd = st[2 * s + 1];
        const float* sg = a.in[7] + g * 128; const float* sb = a.in[8] + g * 128;
#pragma unroll
        for (int i = 0; i < 4; ++i) {
            const int d0 = (dq * 4 + i) * 8; float f[8]; unpack8(*(const u32x4*)(vg + (size_t)(m0 + s) * 512 + g * 128 + d0), f);
#pragma unroll
            for (int e = 0; e < 8; ++e) VT[(d0 + e) * 136 + s] = f2bf((f[e] - mean) * rstd * sg[d0 + e] + sb[d0 + e]);
        }
        const float* W = a.in[9] + (size_t)g * 128 * 128;
        for (int idx = tid; idx < 128 * 32; idx += 512) {
            const int t = idx >> 5, s4 = (idx & 31) * 4; f32x4 w = *(const f32x4*)(W + t * 128 + s4);
#pragma unroll
            for (int e = 0; e < 4; ++e) if (s4 + e > t) w[e] = 0.f;
            *(LAS u32x2*)(Wl + t * 136 + s4) = pack4(w);
        }
    }
    __syncthreads();
    {
        const int t0 = 16 * wid, row = lane & 15, quad = lane >> 4;
        f32x4 acc[8];
#pragma unroll
        for (int db = 0; db < 8; ++db) acc[db] = (f32x4){0.f, 0.f, 0.f, 0.f};
        for (int s0 = 0; s0 < t0 + 16; s0 += 32) {
            const bf16x8 av = *(const LAS bf16x8*)(Wl + (t0 + row) * 136 + s0 + quad * 8);
#pragma unroll
            for (int db = 0; db < 8; ++db) { const bf16x8 bv = *(const LAS bf16x8*)(VT + (db * 16 + row) * 136 + s0 + quad * 8);
                acc[db] = __builtin_amdgcn_mfma_f32_16x16x32_bf16(av, bv, acc[db], 0, 0, 0); }
        }
        const float* sbias = a.in[10] + g * 128;
#pragma unroll
        for (int db = 0; db < 8; ++db)
#pragma unroll
            for (int j = 0; j < 4; ++j) {
                const int t = t0 + quad * 4 + j, d = db * 16 + row; const float sv = acc[db][j] + sbias[t];
                const float uv = bf2f(ug[(size_t)(m0 + t) * 512 + g * 128 + d]);
                mixed[(size_t)(m0 + t) * DM + 512 + g * 128 + d] = f2bf(uv * sv);
            }
    }
    __syncthreads();
}

struct Row16 { f32x4 v[4]; };
__device__ __forceinline__ void row_load(const float* p, int lane, Row16& r) {
#pragma unroll
    for (int i = 0; i < 4; ++i) r.v[i] = *(const f32x4*)(p + 256 * i + 4 * lane);
}
__device__ __forceinline__ void row_ln(Row16& r, const Row16& g, const Row16& b) {
    float s = 0.f;
#pragma unroll
    for (int i = 0; i < 4; ++i) s += (r.v[i][0] + r.v[i][1]) + (r.v[i][2] + r.v[i][3]);
    const float mean = wave_sum(s) * (1.0f / 1024.0f); float q = 0.f;
#pragma unroll
    for (int i = 0; i < 4; ++i) { r.v[i] -= mean; q += r.v[i][0] * r.v[i][0] + r.v[i][1] * r.v[i][1] + r.v[i][2] * r.v[i][2] + r.v[i][3] * r.v[i][3]; }
    const float rstd = rsqrtf(wave_sum(q) * (1.0f / 1024.0f) + 1e-5f);
#pragma unroll
    for (int i = 0; i < 4; ++i) r.v[i] = r.v[i] * rstd * g.v[i] + b.v[i];
}
__device__ __forceinline__ void row_store_bf(bf16_t* p, int lane, const Row16& r) {
#pragma unroll
    for (int i = 0; i < 4; ++i) *(u32x2*)(p + 256 * i + 4 * lane) = pack4(r.v[i]);
}
__device__ void ln_phase(const float* src, float* dstf, bf16_t* dstb, const float* gp, const float* bp) {
    const int tid = tid_opaque(); const int lane = tid & 63, gw = blockIdx.x * 8 + (tid >> 6), nw = gridDim.x * 8;
    Row16 g, b; row_load(gp, lane, g); row_load(bp, lane, b);
    for (int row = gw; row < MT; row += nw) {
        Row16 r; row_load(src + (size_t)row * DM, lane, r); row_ln(r, g, b);
#pragma unroll
        for (int i = 0; i < 4; ++i) *(f32x4*)(dstf + (size_t)row * DM + 256 * i + 4 * lane) = r.v[i];
        if (dstb) row_store_bf(dstb + (size_t)row * DM, lane, r);
    }
}
__device__ void ln_shift_phase(const Args& a) {
    const float* src = (const float*)(a.ws + SLOTP(4)); float* xf = a.out;
    bf16_t* xr = (bf16_t*)(a.ws + SLOTP(0)); bf16_t* xk = (bf16_t*)(a.ws + SLOTP(1)); bf16_t* xv = (bf16_t*)(a.ws + SLOTP(2)); bf16_t* xg = (bf16_t*)(a.ws + SLOTP(3));
    const int tid = tid_opaque(); const int lane = tid & 63, gw = blockIdx.x * 8 + (tid >> 6), nw = gridDim.x * 8;
    Row16 g, b, mr, mk, mv; row_load(a.in[33], lane, g); row_load(a.in[34], lane, b);
    row_load(a.in[13], lane, mr); row_load(a.in[13] + 2 * 1024, lane, mk); row_load(a.in[13] + 3 * 1024, lane, mv);
    for (int ch = gw; ch < MT / 8; ch += nw) {
        const int r0 = ch * 8; Row16 prev;
        if ((r0 & (SEQL - 1)) == 0) {
#pragma unroll
            for (int i = 0; i < 4; ++i) prev.v[i] = (f32x4){0.f, 0.f, 0.f, 0.f};
        } else { row_load(src + (size_t)(r0 - 1) * DM, lane, prev); row_ln(prev, g, b); }
        for (int r = r0; r < r0 + 8; ++r) {
            Row16 cur; row_load(src + (size_t)r * DM, lane, cur); row_ln(cur, g, b);
#pragma unroll
            for (int i = 0; i < 4; ++i) *(f32x4*)(xf + (size_t)r * DM + 256 * i + 4 * lane) = cur.v[i];
            row_store_bf(xg + (size_t)r * DM, lane, cur);
            Row16 t;
#pragma unroll
            for (int i = 0; i < 4; ++i) t.v[i] = cur.v[i] + (prev.v[i] - cur.v[i]) * mr.v[i];
            row_store_bf(xr + (size_t)r * DM, lane, t);
#pragma unroll
            for (int i = 0; i < 4; ++i) t.v[i] = cur.v[i] + (prev.v[i] - cur.v[i]) * mk.v[i];
            row_store_bf(xk + (size_t)r * DM, lane, t);
#pragma unroll
            for (int i = 0; i < 4; ++i) t.v[i] = cur.v[i] + (prev.v[i] - cur.v[i]) * mv.v[i];
            row_store_bf(xv + (size_t)r * DM, lane, t);
            prev = cur;
        }
    }
}

__device__ void hid_phase(const Args& a) {
    const bf16_t* pq = (const bf16_t*)(a.ws + O_W1T); bf16_t* hid = (bf16_t*)(a.ws + O_HID);
    const int t0 = tid_opaque();
    for (int idx = blockIdx.x * 512 + t0; idx < MT * 64; idx += gridDim.x * 512) {
        const int m = idx >> 6, c4 = (idx & 63) * 4;
        const u32x2 q = *(const u32x2*)(pq + (size_t)m * 512 + c4);
        u32x2 p = (u32x2){0u, 0u}; if (m & (SEQL - 1)) p = *(const u32x2*)(pq + (size_t)(m - 1) * 512 + 256 + c4);
        f32x4 v; v[0] = __uint_as_float(q.x << 16) + __uint_as_float(p.x << 16); v[1] = __uint_as_float(q.x & 0xffff0000u) + __uint_as_float(p.x & 0xffff0000u);
        v[2] = __uint_as_float(q.y << 16) + __uint_as_float(p.y << 16); v[3] = __uint_as_float(q.y & 0xffff0000u) + __uint_as_float(p.y & 0xffff0000u);
        if (c4 < 64) {
#pragma unroll
            for (int j = 0; j < 4; ++j) v[j] = 2.0f * sigmoidf_(2.0f * v[j]) - 1.0f;
        } else if (c4 >= 128) {
#pragma unroll
            for (int j = 0; j < 4; ++j) v[j] = sigmoidf_(v[j]);
        }
        *(u32x2*)(hid + (size_t)m * 256 + c4) = pack4(v);
    }
}

constexpr int TC = 32, SBUF = (5 * TC * 64 + TC * 16) * 4;
#define SCAN_BAR() do { asm volatile("s_waitcnt lgkmcnt(0)" ::: "memory"); __builtin_amdgcn_s_barrier(); asm volatile("" ::: "memory"); } while (0)
__device__ void scan_phase(const Args& a, LAS unsigned char* lds) {
    const bf16_t* rp = (const bf16_t*)(a.ws + SLOTP(4)); const bf16_t* kp = (const bf16_t*)(a.ws + SLOTP(5)); const bf16_t* vp = (const bf16_t*)(a.ws + SLOTP(0));
    const bf16_t* ep = (const bf16_t*)(a.ws + SLOTP(1)); const bf16_t* ap = (const bf16_t*)(a.ws + SLOTP(2));
    bf16_t* yraw = (bf16_t*)(a.ws + SLOTP(3)); float* ct = (float*)(a.ws + O_CT);
    const int tid = tid_opaque(), wid = tid >> 6, lane = tid & 63;
    for (int item = blockIdx.x; item < 256; item += gridDim.x) {
        const int xcd = item & 7, slot = item >> 3, hg = xcd * 8 + (slot >> 2), q = slot & 3, bb = hg >> 4, h = hg & 15;
        const size_t mbase = (size_t)bb * SEQL;
        const int col = h * 64 + lane;
        const float kkc = a.in[23][col], kac = a.in[24][col], rkc = a.in[25][col], omk = 1.0f - kac;
        unsigned short rr[8], kk[8], vv[8], ee[8], aa[8];
        const int sw = wid - 4;
        auto stage_load = [&](int c) {
#pragma unroll
            for (int i = 0; i < 8; ++i) { const size_t idx = (mbase + c * TC + sw * 8 + i) * DM + col;
                rr[i] = rp[idx]; kk[i] = kp[idx]; vv[i] = vp[idx]; ee[i] = ep[idx]; aa[i] = ap[idx]; }
        };
        auto stage_proc = [&](int c, int bufi) {
            LAS float* B = (LAS float*)(lds + bufi * SBUF);
#pragma unroll
            for (int i = 0; i < 8; ++i) {
                const int tl = sw * 8 + i;
                const float kf = bf2f(kk[i]), af = bf2f(aa[i]), rf = bf2f(rr[i]);
                const float kkr = kf * kkc; const float ss = wave_sum(kkr * kkr); const float inv = __builtin_amdgcn_rsqf(fmaxf(ss, 1e-24f));
                const float nkk = -kkr * inv; const float kpr = kf * (af * kac + omk);
                B[0 * TC * 64 + tl * 64 + lane] = __expf(-bf2f(ee[i]));
                B[1 * TC * 64 + tl * 64 + lane] = nkk;
                B[2 * TC * 64 + tl * 64 + lane] = -nkk * af;
                B[3 * TC * 64 + tl * 64 + lane] = kpr;
                B[4 * TC * 64 + tl * 64 + lane] = rf;
                if ((lane >> 4) == q) B[5 * TC * 64 + tl * 16 + (lane & 15)] = bf2f(vv[i]);
                if (q == 0) { const float cterm = wave_sum(rf * kpr * rkc); if (lane == 0) ct[(mbase + c * TC + tl) * 16 + h] = cterm; }
            }
        };
        if (wid >= 4) { stage_load(0); stage_proc(0, 0); stage_load(1); }
        SCAN_BAR();
        f32x2 S0 = (f32x2){0.f, 0.f}, S1 = (f32x2){0.f, 0.f};
        const int il = lane >> 4, jl = lane & 15, rowl = 4 * (wid & 3) + il;
        for (int c = 0; c < SEQL / TC; ++c) {
            if (wid >= 4) { if (c + 1 < SEQL / TC) { stage_proc(c + 1, (c + 1) & 1); if (c + 2 < SEQL / TC) stage_load(c + 2); } }
            else {
                const LAS float* B = (const LAS float*)(lds + (c & 1) * SBUF);
                bf16_t* yo = yraw + (mbase + c * TC + jl) * DM + h * 64 + 16 * q + rowl;
#pragma unroll
                for (int t16 = 0; t16 < TC; t16 += 16) {
                    float ykeep = 0.f;
#pragma unroll
                    for (int ts = 0; ts < 16; ++ts) {
                        const int tl = t16 + ts;
                        const f32x4 w4 = *(const LAS f32x4*)(B + 0 * TC * 64 + tl * 64 + 4 * jl), n4 = *(const LAS f32x4*)(B + 1 * TC * 64 + tl * 64 + 4 * jl),
                                    b4 = *(const LAS f32x4*)(B + 2 * TC * 64 + tl * 64 + 4 * jl), k4 = *(const LAS f32x4*)(B + 3 * TC * 64 + tl * 64 + 4 * jl),
                                    r4 = *(const LAS f32x4*)(B + 4 * TC * 64 + tl * 64 + 4 * jl);
                        const float vi = B[5 * TC * 64 + tl * 16 + rowl];
                        const f32x2 vi2 = (f32x2){vi, vi};
                        const f32x2 p = S0 * (f32x2){n4[0], n4[1]} + S1 * (f32x2){n4[2], n4[3]};
                        const float sa = red16(p[0] + p[1]);
                        const f32x2 sa2 = (f32x2){sa, sa};
                        S0 = S0 * (f32x2){w4[0], w4[1]} + (f32x2){k4[0], k4[1]} * vi2;
                        S1 = S1 * (f32x2){w4[2], w4[3]} + (f32x2){k4[2], k4[3]} * vi2;
                        S0 = (f32x2){b4[0], b4[1]} * sa2 + S0;
                        S1 = (f32x2){b4[2], b4[3]} * sa2 + S1;
                        const f32x2 yy = S0 * (f32x2){r4[0], r4[1]} + S1 * (f32x2){r4[2], r4[3]};
                        const float y = red16(yy[0] + yy[1]);
                        ykeep = (jl == ts) ? y : ykeep;
                    }
                    yo[(size_t)t16 * DM] = f2bf(ykeep);
                }
            }
            SCAN_BAR();
        }
        __syncthreads();
    }
}
__device__ void post_phase(const Args& a) {
    const bf16_t* yraw = (const bf16_t*)(a.ws + SLOTP(3)); const bf16_t* vp = (const bf16_t*)(a.ws + SLOTP(0)); const bf16_t* gg = (const bf16_t*)(a.ws + SLOTP(4));
    const float* ct = (const float*)(a.ws + O_CT); bf16_t* yb = (bf16_t*)(a.ws + SLOTP(5));
    const int tid = tid_opaque(); const int lane = tid & 63, gw = blockIdx.x * 8 + (tid >> 6), nw = gridDim.x * 8;
    const int c0 = 16 * lane;
    float lg[16], lb[16];
#pragma unroll
    for (int i = 0; i < 16; ++i) { lg[i] = a.in[26][c0 + i]; lb[i] = a.in[27][c0 + i]; }
    for (int row = gw; row < MT; row += nw) {
        const size_t o = (size_t)row * DM + c0; float y[16], v[16], g[16];
        unpack8(*(const u32x4*)(yraw + o), *(float(*)[8])&y[0]); unpack8(*(const u32x4*)(yraw + o + 8), *(float(*)[8])&y[8]);
        unpack8(*(const u32x4*)(vp + o), *(float(*)[8])&v[0]); unpack8(*(const u32x4*)(vp + o + 8), *(float(*)[8])&v[8]);
        unpack8(*(const u32x4*)(gg + o), *(float(*)[8])&g[0]); unpack8(*(const u32x4*)(gg + o + 8), *(float(*)[8])&g[8]);
        const float cv = ct[(size_t)row * 16 + (lane >> 2)];
        float s = 0.f;
#pragma unroll
        for (int i = 0; i < 16; ++i) s += y[i];
        s += dpp_mov<0xB1>(s); s += dpp_mov<0x4E>(s);
        const float mean = s * (1.0f / 64.0f); float qq = 0.f;
#pragma unroll
        for (int i = 0; i < 16; ++i) { y[i] -= mean; qq += y[i] * y[i]; }
        qq += dpp_mov<0xB1>(qq); qq += dpp_mov<0x4E>(qq);
        const float rstd = rsqrtf(qq * (1.0f / 64.0f) + 64e-5f);
        u32x4 w0, w1; float of[16];
#pragma unroll
        for (int i = 0; i < 16; ++i) of[i] = (y[i] * rstd * lg[i] + lb[i] + cv * v[i]) * g[i];
#pragma unroll
        for (int i = 0; i < 4; ++i) { w0[i] = cvt_pk_bf16(of[2 * i], of[2 * i + 1]); w1[i] = cvt_pk_bf16(of[8 + 2 * i], of[8 + 2 * i + 1]); }
        *(u32x4*)(yb + o) = w0; *(u32x4*)(yb + o + 8) = w1;
    }
}

#define XB_TMO      128
#define XB_XCNT(j)  (256  + 64 * (j))
#define XB_XSUB(j)  (1280 + 64 * (j))
#define XB_XGEN(j)  (2304 + 64 * (j))
#define XB_TOP      3328
#define XB_TOPGEN   3392
#define XCD_BAR_WORDS 3456
#define XB_SPIN_CAP (1u << 18)

__device__ __forceinline__ unsigned xb_ld(unsigned* p)              { return __hip_atomic_load(p, __ATOMIC_RELAXED, __HIP_MEMORY_SCOPE_AGENT); }
__device__ __forceinline__ unsigned xb_add(unsigned* p, unsigned v) { return __hip_atomic_fetch_add(p, v, __ATOMIC_RELAXED, __HIP_MEMORY_SCOPE_AGENT); }
__device__ __forceinline__ unsigned xb_xcc_id() { return (unsigned)__builtin_amdgcn_s_getreg((3 << 11) | 20) & 0xFu; }
#define XB_SPIN(cond, bar) do { unsigned _sp = 0; while (cond) { __builtin_amdgcn_s_sleep(1); \
    if ((++_sp & 255u) == 0u) { if (xb_ld(&(bar)[XB_TMO])) break; if (_sp > XB_SPIN_CAP) { atomicAdd(&(bar)[XB_TMO], 1u); break; } } } } while (0)

struct XcdBarrier {
    unsigned* bar; unsigned x;
    volatile LAS unsigned* st;
};

__device__ __forceinline__ XcdBarrier xcd_barrier_post(unsigned* bar, volatile LAS unsigned* st) {
    XcdBarrier b; b.bar = bar; b.x = xb_xcc_id(); b.st = st;
    if (threadIdx.x == 0) (void)xb_add(&bar[XB_XCNT(b.x)], 1u);
    return b;
}
__device__ __forceinline__ void xcd_barrier_complete(unsigned* bar, unsigned x, unsigned& nloc, unsigned& nx) {
    const unsigned G = gridDim.x * gridDim.y * gridDim.z;
    unsigned sum, cnt, mine, sp = 0u;
    for (;;) {
        sum = 0u; cnt = 0u; mine = 0u;
#pragma unroll
        for (unsigned j = 0; j < 16; ++j) { const unsigned c = xb_ld(&bar[XB_XCNT(j)]); sum += c; cnt += (c > 0u) ? 1u : 0u; mine = (j == x) ? c : mine; }
        if (sum == G) break;
        __builtin_amdgcn_s_sleep(1);
        if ((++sp & 255u) == 0u) { if (xb_ld(&bar[XB_TMO])) break; if (sp > XB_SPIN_CAP) { atomicAdd(&bar[XB_TMO], 1u); break; } }
    }
    nloc = mine > 0u ? mine : 1u; nx = cnt > 0u ? cnt : 1u;
}

__device__ __forceinline__ void xcd_barrier(const XcdBarrier& b) {
    asm volatile("s_waitcnt vmcnt(0)" ::: "memory");
    __syncthreads();
    if (threadIdx.x == 0) {
        unsigned* bar = b.bar;
        __builtin_amdgcn_s_waitcnt(0);
        unsigned nloc = b.st[0], nx = b.st[1];
        if (nloc == 0u) { xcd_barrier_complete(bar, b.x, nloc, nx); b.st[0] = nloc; b.st[1] = nx; }
        const unsigned old = xb_add(&bar[XB_XSUB(b.x)], 1u);
        const unsigned gen = old / nloc;
        if (old + 1u == (gen + 1u) * nloc) {
            __builtin_amdgcn_fence(__ATOMIC_RELEASE, "agent");
            asm volatile("s_waitcnt vmcnt(0)" ::: "memory");
            const unsigned og = xb_add(&bar[XB_TOP], 1u);
            const unsigned tg = og / nx;
            if (og + 1u == (tg + 1u) * nx) xb_add(&bar[XB_TOPGEN], 1u);
            else XB_SPIN(xb_ld(&bar[XB_TOPGEN]) == tg, bar);
            __builtin_amdgcn_fence(__ATOMIC_ACQUIRE, "agent");
            xb_add(&bar[XB_XGEN(b.x)], 1u);
            asm volatile("s_waitcnt vmcnt(0)" ::: "memory");
        } else {
            XB_SPIN(xb_ld(&bar[XB_XGEN(b.x)]) == gen, bar);
            __builtin_amdgcn_fence(__ATOMIC_ACQUIRE, "agent");
            asm volatile("s_waitcnt vmcnt(0)" ::: "memory");
        }
    }
    __syncthreads();
}


__device__ __forceinline__ void grid_barrier(unsigned* cnt, unsigned& epoch) {
    __syncthreads();
    epoch += gridDim.x;
    if (threadIdx.x == 0) {
        __builtin_amdgcn_fence(__ATOMIC_RELEASE, "agent");
        __hip_atomic_fetch_add(cnt, 1u, __ATOMIC_RELAXED, __HIP_MEMORY_SCOPE_AGENT);
        while (__hip_atomic_load(cnt, __ATOMIC_RELAXED, __HIP_MEMORY_SCOPE_AGENT) < epoch) __builtin_amdgcn_s_sleep(1);
        __builtin_amdgcn_fence(__ATOMIC_ACQUIRE, "agent");
    }
    __syncthreads();
}
constexpr int NPHASE = 19;
constexpr int LDS_TOTAL = STAGE_BYTES + 16;
__global__ void __launch_bounds__(512, 2) mk_fwd(Args a) {
    extern __shared__ __attribute__((aligned(16))) unsigned char smem[];
    LAS unsigned char* lds = (LAS unsigned char*)smem;
    cg::grid_group grid = cg::this_grid();
    unsigned char* ws = a.ws;
    volatile LAS unsigned* xst = (volatile LAS unsigned*)(lds + STAGE_BYTES);
    if (threadIdx.x == 0) { xst[0] = 0u; xst[1] = 0u; xst[2] = 0u; xst[3] = 0u; }
    __syncthreads();
    const XcdBarrier xbar = xcd_barrier_post((unsigned*)(ws + O_BAR), xst);
    if (a.ph_hi < 0) grid.sync();
#define GSYNC() xcd_barrier(xbar)
#define BFP(off) ((bf16_t*)(ws + (off)))
    if (a.ph_lo <= 0 && 0 < a.ph_hi) { if (ONLY < 0 || ONLY == 0) { for (int rep_ = 0; rep_ < (DUP == 0 ? 2 : 1); ++rep_) { if (rep_) GSYNC(); prep_phase(a, lds); } }
        if (0 + 1 < a.ph_hi) GSYNC(); }
    if (a.ph_lo <= 1 && 1 < a.ph_hi) { if (ONLY < 0 || ONLY == 1) { for (int rep_ = 0; rep_ < (DUP == 1 ? 2 : 1); ++rep_) { if (rep_) GSYNC(); { StaticOrder S{64, 8, 2048, 2048}; EpiG1 E{BFP(SLOTP(1)), BFP(SLOTP(1) + 16 * MiB), BFP(SLOTP(2)), a.in[2]};
            gemm_phase(lds, BFP(SLOTP(0)), BFP(O_W1T), 1024, 2048, S, E); } } }
        if (1 + 1 < a.ph_hi) GSYNC(); }
    if (a.ph_lo <= 2 && 2 < a.ph_hi) { if (ONLY < 0 || ONLY == 2) { for (int rep_ = 0; rep_ < (DUP == 2 ? 2 : 1); ++rep_) { if (rep_) GSYNC(); { for (int t = blockIdx.x; t < 512; t += gridDim.x) conv_tile(a, lds, t);
            for (int t = blockIdx.x; t < 512; t += gridDim.x) sgu_item(a, lds, t); } } }
        if (2 + 1 < a.ph_hi) GSYNC(); }
    if (a.ph_lo <= 3 && 3 < a.ph_hi) { if (ONLY < 0 || ONLY == 3) { for (int rep_ = 0; rep_ < (DUP == 3 ? 2 : 1); ++rep_) { if (rep_) GSYNC(); { StaticOrder S{64, 4, 2048, 2048}; EpiRes E{a.in[0], a.out, a.in[12]}; gemm_phase(lds, BFP(SLOTP(3)), BFP(O_W2T), 1024, 2048, S, E); } } }
        if (3 + 1 < a.ph_hi) GSYNC(); }
    if (a.ph_lo <= 4 && 4 < a.ph_hi) { if (ONLY < 0 || ONLY == 4) { for (int rep_ = 0; rep_ < (DUP == 4 ? 2 : 1); ++rep_) { if (rep_) GSYNC(); ln_phase(a.out, a.out, BFP(SLOTP(0)), a.in[31], a.in[32]); } }
        if (4 + 1 < a.ph_hi) GSYNC(); }
    if (a.ph_lo <= 5 && 5 < a.ph_hi) { if (ONLY < 0 || ONLY == 5) { for (int rep_ = 0; rep_ < (DUP == 5 ? 2 : 1); ++rep_) { if (rep_) GSYNC(); { StaticOrder S{64, 22, 2048, 2048}; EpiSwiglu E{BFP(SLOTP(1))}; gemm_phase(lds, BFP(SLOTP(0)), BFP(O_F1T0), 1024, 2048, S, E); } } }
        if (5 + 1 < a.ph_hi) GSYNC(); }
    if (a.ph_lo <= 6 && 6 < a.ph_hi) { if (ONLY < 0 || ONLY == 6) { for (int rep_ = 0; rep_ < (DUP == 6 ? 2 : 1); ++rep_) { if (rep_) GSYNC(); { StaticOrder S{64, 4, 2 * FH, 2 * FH}; EpiRes E{a.out, (float*)(ws + SLOTP(4)), nullptr}; gemm_phase(lds, BFP(SLOTP(1)), BFP(O_F2T0), FH, 2 * FH, S, E); } } }
        if (6 + 1 < a.ph_hi) GSYNC(); }
    if (a.ph_lo <= 7 && 7 < a.ph_hi) { if (ONLY < 0 || ONLY == 7) { for (int rep_ = 0; rep_ < (DUP == 7 ? 2 : 1); ++rep_) { if (rep_) GSYNC(); ln_shift_phase(a); } }
        if (7 + 1 < a.ph_hi) GSYNC(); }
    if (a.ph_lo <= 8 && 8 < a.ph_hi) { if (ONLY < 0 || ONLY == 8) { for (int rep_ = 0; rep_ < (DUP == 8 ? 2 : 1); ++rep_) { if (rep_) GSYNC(); { StaticOrder S2{64, 2, 2048, 2048}; EpiBf<3> E2{BFP(O_W1T), nullptr, 0, nullptr, nullptr}; gemm_phase(lds, BFP(SLOTP(3)), BFP(O_WL1), 1024, 2048, S2, E2);
            GroupOrder S{2, SLOT}; EpiBf<0> E{BFP(SLOTP(4)), nullptr, SLOT / 2, nullptr, nullptr}; gemm_phase(lds, BFP(SLOTP(0)), BFP(O_WRKV), 1024, 2048, S, E); } } }
        if (8 + 1 < a.ph_hi) GSYNC(); }
    if (a.ph_lo <= 9 && 9 < a.ph_hi) { if (ONLY < 0 || ONLY == 9) { for (int rep_ = 0; rep_ < (DUP == 9 ? 2 : 1); ++rep_) { if (rep_) GSYNC(); { StaticOrder S{64, 4, 2048, 2048}; EpiBf<0> E{BFP(SLOTP(0)), nullptr, 0, nullptr, nullptr}; gemm_phase(lds, BFP(SLOTP(2)), BFP(O_WRKV + 4 * MiB), 1024, 2048, S, E); hid_phase(a); } } }
        if (9 + 1 < a.ph_hi) GSYNC(); }
    if (a.ph_lo <= 10 && 10 < a.ph_hi) { if (ONLY < 0 || ONLY == 10) { for (int rep_ = 0; rep_ < (DUP == 10 ? 2 : 1); ++rep_) { if (rep_) GSYNC(); { StaticOrder S{64, 4, 512, 512}; EpiBf<2> E{BFP(SLOTP(1)), nullptr, 0, a.in[15], nullptr}; gemm_phase(lds, BFP(O_HID), BFP(O_L2T), 256, 512, S, E);
            EpiBf<4> E2{BFP(SLOTP(2)), nullptr, 0, a.in[18], nullptr}; gemm_phase(lds, BFP(O_HID), BFP(O_L2T + 512 * 1024), 256, 512, S, E2); } } }
        if (10 + 1 < a.ph_hi) GSYNC(); }
    if (a.ph_lo <= 11 && 11 < a.ph_hi) { if (ONLY < 0 || ONLY == 11) { for (int rep_ = 0; rep_ < (DUP == 11 ? 2 : 1); ++rep_) { if (rep_) GSYNC(); scan_phase(a, lds); } }
        if (11 + 1 < a.ph_hi) GSYNC(); }
    if (a.ph_lo <= 12 && 12 < a.ph_hi) { if (ONLY < 0 || ONLY == 12) { for (int rep_ = 0; rep_ < (DUP == 12 ? 2 : 1); ++rep_) { if (rep_) GSYNC(); { StaticOrder S{64, 4, 512, 512}; EpiBf<0> E{BFP(SLOTP(4)), nullptr, 0, nullptr, nullptr}; gemm_phase(lds, BFP(O_HID), BFP(O_L2T + 1 * MiB), 256, 512, S, E); } } }
        if (12 + 1 < a.ph_hi) GSYNC(); }
    if (a.ph_lo <= 13 && 13 < a.ph_hi) { if (ONLY < 0 || ONLY == 13) { for (int rep_ = 0; rep_ < (DUP == 13 ? 2 : 1); ++rep_) { if (rep_) GSYNC(); post_phase(a); } }
        if (13 + 1 < a.ph_hi) GSYNC(); }
    if (a.ph_lo <= 14 && 14 < a.ph_hi) { if (ONLY < 0 || ONLY == 14) { for (int rep_ = 0; rep_ < (DUP == 14 ? 2 : 1); ++rep_) { if (rep_) GSYNC(); { StaticOrder S{64, 4, 2048, 2048}; EpiRes E{a.out, a.out, nullptr}; gemm_phase(lds, BFP(SLOTP(5)), BFP(O_WOT), 1024, 2048, S, E); } } }
        if (14 + 1 < a.ph_hi) GSYNC(); }
    if (a.ph_lo <= 15 && 15 < a.ph_hi) { if (ONLY < 0 || ONLY == 15) { for (int rep_ = 0; rep_ < (DUP == 15 ? 2 : 1); ++rep_) { if (rep_) GSYNC(); ln_phase(a.out, a.out, BFP(SLOTP(0)), a.in[31] + 1024, a.in[32] + 1024); } }
        if (15 + 1 < a.ph_hi) GSYNC(); }
    if (a.ph_lo <= 16 && 16 < a.ph_hi) { if (ONLY < 0 || ONLY == 16) { for (int rep_ = 0; rep_ < (DUP == 16 ? 2 : 1); ++rep_) { if (rep_) GSYNC(); { StaticOrder S{64, 22, 2048, 2048}; EpiSwiglu E{BFP(SLOTP(1))}; gemm_phase(lds, BFP(SLOTP(0)), BFP(O_F1T1), 1024, 2048, S, E); } } }
        if (16 + 1 < a.ph_hi) GSYNC(); }
    if (a.ph_lo <= 17 && 17 < a.ph_hi) { if (ONLY < 0 || ONLY == 17) { for (int rep_ = 0; rep_ < (DUP == 17 ? 2 : 1); ++rep_) { if (rep_) GSYNC(); { StaticOrder S{64, 4, 2 * FH, 2 * FH}; EpiRes E{a.out, a.out, nullptr}; gemm_phase(lds, BFP(SLOTP(1)), BFP(O_F2T1), FH, 2 * FH, S, E); } } }
        if (17 + 1 < a.ph_hi) GSYNC(); }
    if (a.ph_lo <= 18 && 18 < a.ph_hi) { if (ONLY < 0 || ONLY == 18) { for (int rep_ = 0; rep_ < (DUP == 18 ? 2 : 1); ++rep_) { if (rep_) GSYNC(); ln_phase(a.out, a.out, nullptr, a.in[33] + 1024, a.in[34] + 1024); } }
        if (18 + 1 < a.ph_hi) GSYNC(); }
    if (a.ph_lo <= 19 && 19 < a.ph_hi) { const bf16_t* src = BFP(DUMP_OFF); const int t0 = tid_opaque();
        for (size_t i = (size_t)blockIdx.x * 512 + t0; i < (size_t)MT * DM; i += (size_t)gridDim.x * 512) a.out[i] = bf2f(src[i]); }
#ifdef EXTRA_SYNCS
    if (a.ph_hi == NPHASE) { for (int i = 0; i < 16; ++i) grid.sync(); }
#endif
#undef BFP
}

extern "C" void kernel_launch(void* const* d_in, const int* in_sizes, int n_in, void* d_out, int out_size, void* d_ws, size_t ws_size, hipStream_t stream) {
    static int grid_blocks = 0;
    if (grid_blocks == 0) {
        if (n_in != 35 || out_size != MT * DM || ws_size < WS_END) { fprintf(stderr, "kernel_launch: unexpected shapes (n_in %d out %d ws %zu need %zu)\n", n_in, out_size, ws_size, (size_t)WS_END); grid_blocks = -1; return; }
        int dev = 0, cus = 0, per_cu = 0;
        hipGetDevice(&dev); hipDeviceGetAttribute(&cus, hipDeviceAttributeMultiprocessorCount, dev);
        hipFuncSetAttribute((const void*)mk_fwd, hipFuncAttributeMaxDynamicSharedMemorySize, LDS_TOTAL);
        hipOccupancyMaxActiveBlocksPerMultiprocessor(&per_cu, (const void*)mk_fwd, 512, LDS_TOTAL);
        if (per_cu < 1) per_cu = 1;
        grid_blocks = cus * per_cu;
        if (grid_blocks > 256) grid_blocks = 256;
    }
    if (grid_blocks < 0) return;
    if (hipMemsetAsync((char*)d_ws + O_BAR, 0, XCD_BAR_WORDS * 4, stream) != hipSuccess) { fprintf(stderr, "kernel_launch: memset of barrier words failed\n"); return; }
    Args a{};
    for (int i = 0; i < 35; ++i) a.in[i] = (const float*)d_in[i];
    a.out = (float*)d_out; a.ws = (unsigned char*)d_ws;
#if PER_PHASE_LAUNCH
    for (int ph = 0; ph < NPHASE && ph <= STOP_AFTER; ++ph) {
        a.ph_lo = ph; a.ph_hi = ph + 1; void* args[] = {&a};
        hipError_t e = hipLaunchCooperativeKernel((const void*)mk_fwd, dim3(grid_blocks), dim3(512), args, LDS_TOTAL, stream);
        if (e != hipSuccess) { fprintf(stderr, "cooperative launch failed: %s\n", hipGetErrorString(e)); return; }
    }
    if (STOP_AFTER < NPHASE - 1) { a.ph_lo = 19; a.ph_hi = 20; void* args[] = {&a};
        (void)hipLaunchCooperativeKernel((const void*)mk_fwd, dim3(grid_blocks), dim3(512), args, LDS_TOTAL, stream); }
#else
    a.ph_lo = 0; a.ph_hi = NPHASE; void* args[] = {&a};
    hipError_t e = hipLaunchCooperativeKernel((const void*)mk_fwd, dim3(grid_blocks), dim3(512), args, LDS_TOTAL, stream);
    if (e != hipSuccess) fprintf(stderr, "cooperative launch failed: %s (grid %d)\n", hipGetErrorString(e), grid_blocks);
#endif
}
```
